# Optimizing an MI355X kernel written in HIP

```python
import math
import jax
import jax.numpy as jnp
from jax import lax
import numpy as np

D_MODEL = 1024
BATCH = 2
SEQ = 16384
DEPTH = 2

GRID_W = 64
CTX_LEN = 256
Q_BLOCK = 128
HEAD_DIM = 64
ROPE_THETA = 10000.0
A_HEADS = 4
A_KV_HEADS = 2
DIFF_HEADS = 4
DIFF_DIM = 32
WIN_HEADS = 4
WIN_KV_HEADS = 2
WINDOW = 128
RET_HEADS = 4
RET_DK = 64
RET_DV = 64
RET_CHUNK = 128
N_BRANCH = 4
BRANCH_W = 256
PIECES = (
    A_HEADS * HEAD_DIM, A_KV_HEADS * HEAD_DIM, A_KV_HEADS * HEAD_DIM,
    2 * DIFF_HEADS * DIFF_DIM, 2 * DIFF_HEADS * DIFF_DIM, DIFF_HEADS * 2 * DIFF_DIM,
    WIN_HEADS * HEAD_DIM, WIN_KV_HEADS * HEAD_DIM, WIN_KV_HEADS * HEAD_DIM,
    RET_HEADS * RET_DK, RET_HEADS * RET_DK, RET_HEADS * RET_DV, RET_HEADS * RET_DV,
)
MIX_COLS = sum(PIECES)
IN_COLS = MIX_COLS + N_BRANCH * D_MODEL
PEER_HEADS = 8
PEER_NK = 128
PEER_N = PEER_NK * PEER_NK
PEER_TOPK = 16
PEER_DQ = 128
PEER_BLOCK = 128
DEEPNORM_ALPHA = (2 * DEPTH) ** 0.25
DEEPNORM_BETA = (8 * DEPTH) ** -0.25
LN_EPS = 1e-5
RMS_EPS = 1e-6
F32 = jnp.float32

kernel_name = 'hybrid_dit_gqa_diff_window_retention_peer'


def layer_norm(x, p):
    xf = x.astype(F32)
    mu = jnp.mean(xf, -1, keepdims=True)
    var = jnp.mean(jnp.square(xf - mu), -1, keepdims=True)
    return ((xf - mu) * lax.rsqrt(var + LN_EPS) * p[0].astype(F32) + p[1].astype(F32)).astype(x.dtype)


def rms_norm(x, g):
    xf = x.astype(F32)
    return (xf * lax.rsqrt(jnp.mean(xf * xf, -1, keepdims=True) + RMS_EPS) * g.astype(F32)).astype(x.dtype)


def to_heads(t, n):
    b, l, _ = t.shape
    return t.reshape(b, l, n, -1).transpose(0, 2, 1, 3)


def from_heads(t):
    b, h, l, d = t.shape
    return t.transpose(0, 2, 1, 3).reshape(b, l, h * d)


def split_pieces(p):
    out, start = [], 0
    for w in PIECES:
        out.append(p[..., start:start + w])
        start += w
    return out


def axial_tables(row, col, d):
    quarter = d // 4
    inv = ROPE_THETA ** (-jnp.arange(quarter, dtype=F32) / quarter)
    ang = jnp.stack([row[:, None] * inv, col[:, None] * inv], axis=1)
    return jnp.cos(ang), jnp.sin(ang)


def apply_axial(x, cs):
    cos, sin = cs
    d = x.shape[-1]
    xs = x.astype(F32).reshape(x.shape[:-1] + (2, 2, d // 4))
    x1, x2 = xs[..., 0, :], xs[..., 1, :]
    out = jnp.stack([x1 * cos - x2 * sin, x2 * cos + x1 * sin], axis=-2)
    return out.reshape(x.shape).astype(x.dtype)


def rope1d_tables(pos, d):
    half = d // 2
    inv = ROPE_THETA ** (-jnp.arange(half, dtype=F32) / half)
    ang = pos[:, None] * inv
    return jnp.cos(ang), jnp.sin(ang)


def apply_rope1d(x, cs):
    cos, sin = cs
    xf = x.astype(F32)
    half = x.shape[-1] // 2
    x1, x2 = xf[..., :half], xf[..., half:]
    return jnp.concatenate([x1 * cos - x2 * sin, x2 * cos + x1 * sin], -1).astype(x.dtype)


def sink_softmax(s, sink):
    m = jnp.maximum(jnp.max(s, -1, keepdims=True), sink)
    e = jnp.exp(s - m)
    return e / (jnp.sum(e, -1, keepdims=True) + jnp.exp(sink - m))


def gqa_blocked(q, k, v):
    b, hq, s, d = q.shape
    hkv = k.shape[1]
    g = hq // hkv
    nb = s // Q_BLOCK
    scale = d ** -0.5
    qb = q.reshape(b, hkv, g, nb, Q_BLOCK, d).transpose(3, 0, 1, 2, 4, 5)

    def one(qblk):
        sc = jnp.einsum('bkgqd,bkld->bkgql', qblk, k, preferred_element_type=F32) * scale
        p = jax.nn.softmax(sc, axis=-1).astype(v.dtype)
        return jnp.einsum('bkgql,bkle->bkgqe', p, v)

    o = lax.map(one, qb)
    return o.transpose(1, 2, 3, 0, 4, 5).reshape(b, hq, s, v.shape[-1])


def diff_blocked(q1, q2, k1, k2, v, lam):
    b, h, s, d = q1.shape
    nb = s // Q_BLOCK
    scale = d ** -0.5

    def blocks(t):
        return t.reshape(b, h, nb, Q_BLOCK, d).transpose(2, 0, 1, 3, 4)

    def one(qs):
        a1, a2 = qs
        p1 = jax.nn.softmax(jnp.einsum('bhqd,bhkd->bhqk', a1, k1, preferred_element_type=F32) * scale, axis=-1)
        p2 = jax.nn.softmax(jnp.einsum('bhqd,bhkd->bhqk', a2, k2, preferred_element_type=F32) * scale, axis=-1)
        return jnp.einsum('bhqk,bhke->bhqe', (p1 - lam * p2).astype(v.dtype), v)

    o = lax.map(one, (blocks(q1), blocks(q2)))
    return o.transpose(1, 2, 0, 3, 4).reshape(b, h, s, v.shape[-1])


def window_attn(q, k, v, kc, vc, sink):
    b, hq, s, d = q.shape
    hkv = k.shape[1]
    g = hq // hkv
    nb = s // Q_BLOCK
    scale = d ** -0.5
    qb = q.reshape(b, hkv, g, nb, Q_BLOCK, d)

    def band(t):
        tp = jnp.pad(t, ((0, 0), (0, 0), (Q_BLOCK, Q_BLOCK), (0, 0)))
        tp = tp.reshape(b, hkv, nb + 2, Q_BLOCK, t.shape[-1])
        return jnp.concatenate([tp[:, :, :-2], tp[:, :, 1:-1], tp[:, :, 2:]], axis=3)

    kw, vw = band(k), band(v)
    qi = jnp.arange(Q_BLOCK)[:, None]
    kj = jnp.arange(3 * Q_BLOCK)[None, :]
    in_band = jnp.abs(Q_BLOCK + qi - kj) <= WINDOW
    kpos = (jnp.arange(nb)[:, None] - 1) * Q_BLOCK + kj
    mask = in_band[None] & ((kpos >= 0) & (kpos < s))[:, None, :]
    s_loc = jnp.einsum('bkgnqd,bknld->bkgnql', qb, kw, preferred_element_type=F32) * scale
    s_loc = jnp.where(mask, s_loc, -jnp.inf)
    s_ctx = jnp.einsum('bkgnqd,bkcd->bkgnqc', qb, kc, preferred_element_type=F32) * scale
    p = sink_softmax(jnp.concatenate([s_loc, s_ctx], -1), sink.astype(F32).reshape(1, hkv, g, 1, 1, 1))
    p = p.astype(v.dtype)
    nl = 3 * Q_BLOCK
    o = (jnp.einsum('bkgnql,bknle->bkgnqe', p[..., :nl], vw)
         + jnp.einsum('bkgnqc,bkce->bkgnqe', p[..., nl:], vc))
    return o.reshape(b, hq, s, v.shape[-1])


def ctx_sink_attn(q, kc, vc, sink):
    b, hq, l, d = q.shape
    hkv = kc.shape[1]
    g = hq // hkv
    sc = jnp.einsum('bkgqd,bkcd->bkgqc', q.reshape(b, hkv, g, l, d), kc, preferred_element_type=F32) * d ** -0.5
    p = sink_softmax(sc, sink.astype(F32).reshape(1, hkv, g, 1, 1)).astype(vc.dtype)
    return jnp.einsum('bkgqc,bkce->bkgqe', p, vc).reshape(b, hq, l, vc.shape[-1])


def retention_chunked(q, k, v, log_gamma, s0):
    b, h, l, _ = q.shape
    n = l // RET_CHUNK
    q, k, v = q.astype(F32), k.astype(F32), v.astype(F32)
    idx = jnp.arange(RET_CHUNK, dtype=F32)
    diff = idx[:, None] - idx[None, :]
    lg = log_gamma.astype(F32)
    dmat = jnp.exp(jnp.where(diff[None] >= 0, diff[None] * lg[:, None, None], -jnp.inf))
    xi = jnp.exp((idx + 1.0)[None] * lg[:, None])
    zeta = jnp.exp((RET_CHUNK - 1.0 - idx)[None] * lg[:, None])
    g_chunk = jnp.exp(RET_CHUNK * lg)

    def chunks(t):
        return t.reshape(b, h, n, RET_CHUNK, t.shape[-1]).transpose(2, 0, 1, 3, 4)

    def step(st, inp):
        qc, kc, vc = inp
        inner = jnp.einsum('bhid,bhjd->bhij', qc, kc) * dmat
        o = jnp.einsum('bhij,bhjv->bhiv', inner, vc) + jnp.einsum('bhid,bhdv->bhiv', qc, st) * xi[..., None]
        st = st * g_chunk[:, None, None] + jnp.einsum('bhjd,bhjv->bhdv', kc * zeta[..., None], vc)
        return st, o

    s_fin, o = lax.scan(step, s0.astype(F32), (chunks(q), chunks(k), chunks(v)))
    return o.transpose(1, 2, 0, 3, 4).reshape(b, h, l, v.shape[-1]), s_fin


def mixer_gqa(lat, cx, gain, ax, need_ctx):
    q = apply_axial(rms_norm(to_heads(lat[0], A_HEADS), gain[0]), ax)
    k = apply_axial(rms_norm(to_heads(lat[1], A_KV_HEADS), gain[1]), ax)
    v = to_heads(lat[2], A_KV_HEADS)
    kc = rms_norm(to_heads(cx[1], A_KV_HEADS), gain[1])
    vc = to_heads(cx[2], A_KV_HEADS)
    o = gqa_blocked(q, jnp.concatenate([kc, k], 2), jnp.concatenate([vc, v], 2))
    oc = None
    if need_ctx:
        oc = from_heads(gqa_blocked(rms_norm(to_heads(cx[0], A_HEADS), gain[0]), kc, vc))
    return from_heads(o), oc


def diff_heads(t):
    b, l, _ = t.shape
    t = t.reshape(b, l, DIFF_HEADS, 2, DIFF_DIM).transpose(3, 0, 2, 1, 4)
    return t[0], t[1]


def mixer_diff(lat, cx, lam_p, subln, layer, ax, need_ctx):
    lam_init = 0.8 - 0.6 * math.exp(-0.3 * layer)
    lp = lam_p.astype(F32)
    lam = jnp.exp(jnp.sum(lp[0] * lp[1])) - jnp.exp(jnp.sum(lp[2] * lp[3])) + lam_init
    q1, q2 = diff_heads(lat[0])
    k1, k2 = diff_heads(lat[1])
    q1, q2, k1, k2 = apply_axial(q1, ax), apply_axial(q2, ax), apply_axial(k1, ax), apply_axial(k2, ax)
    v = to_heads(lat[2], DIFF_HEADS)
    ck1, ck2 = diff_heads(cx[1])
    cv = to_heads(cx[2], DIFF_HEADS)

    def post(o):
        return from_heads(rms_norm(o, subln) * (1.0 - lam_init))

    o = diff_blocked(q1, q2, jnp.concatenate([ck1, k1], 2), jnp.concatenate([ck2, k2], 2),
                     jnp.concatenate([cv, v], 2), lam)
    oc = None
    if need_ctx:
        cq1, cq2 = diff_heads(cx[0])
        oc = post(diff_blocked(cq1, cq2, ck1, ck2, cv, lam))
    return post(o), oc


def mixer_window(lat, cx, sink, ax, need_ctx):
    q = apply_axial(to_heads(lat[0], WIN_HEADS), ax)
    k = apply_axial(to_heads(lat[1], WIN_KV_HEADS), ax)
    v = to_heads(lat[2], WIN_KV_HEADS)
    kc = to_heads(cx[1], WIN_KV_HEADS)
    vc = to_heads(cx[2], WIN_KV_HEADS)
    o = from_heads(window_attn(q, k, v, kc, vc, sink))
    oc = None
    if need_ctx:
        oc = from_heads(ctx_sink_attn(to_heads(cx[0], WIN_HEADS), kc, vc, sink))
    return o, oc


def mixer_retention(lat, cx, decay, norm, rope_lat, rope_ctx, need_ctx):
    lg = jax.nn.log_sigmoid(decay.astype(F32))

    def qkv(p, rope):
        q = apply_rope1d(to_heads(p[0], RET_HEADS), rope)
        k = apply_rope1d(to_heads(p[1], RET_HEADS), rope) * (RET_DK ** -0.5)
        return q, k, to_heads(p[2], RET_HEADS)

    def flip(t):
        return jnp.flip(t, axis=2)

    def finish(o, g):
        mu = jnp.mean(o, -1, keepdims=True)
        var = jnp.mean(jnp.square(o - mu), -1, keepdims=True)
        on = from_heads((o - mu) * lax.rsqrt(var + LN_EPS)) * norm[0].astype(F32) + norm[1].astype(F32)
        return (on * jax.nn.silu(g.astype(F32))).astype(g.dtype)

    qc, kc, vc = qkv(cx, rope_ctx)
    ql, kl, vl = qkv(lat, rope_lat)
    zero = jnp.zeros((qc.shape[0], RET_HEADS, RET_DK, RET_DV), F32)
    ocf, sf = retention_chunked(qc, kc, vc, lg[0], zero)
    ocb, sb = retention_chunked(flip(qc), flip(kc), flip(vc), lg[1], zero)
    olf, _ = retention_chunked(ql, kl, vl, lg[0], sf)
    olb, _ = retention_chunked(flip(ql), flip(kl), flip(vl), lg[1], sb)
    o = finish(olf + flip(olb), lat[3])
    oc = finish(ocf + flip(ocb), cx[3]) if need_ctx else None
    return o, oc


def merge_branches(u, outs, w_gate, w_branch, w_out):
    d = u.shape[-1]
    m = sum(jax.nn.sigmoid(u @ w_gate[:, i * d:(i + 1) * d]) * (o @ w_branch[i]) for i, o in enumerate(outs))
    return m @ w_out


def peer_ffn(u, wq, subkeys, tab_u, tab_v):
    b, l, d = u.shape
    tok = u.reshape(-1, PEER_BLOCK, d)

    def block(xb):
        q = (xb @ wq).reshape(PEER_BLOCK, PEER_HEADS, 2, PEER_DQ)
        s = jnp.einsum('thpk,hpnk->thpn', q, subkeys, preferred_element_type=F32)
        sv, si = lax.top_k(s, PEER_TOPK)
        cand = (sv[:, :, 0, :, None] + sv[:, :, 1, None, :]).reshape(PEER_BLOCK, PEER_HEADS, PEER_TOPK * PEER_TOPK)
        cidx = (si[:, :, 0, :, None] * PEER_NK + si[:, :, 1, None, :]).reshape(PEER_BLOCK, PEER_HEADS, PEER_TOPK * PEER_TOPK)
        fv, fi = lax.top_k(cand, PEER_TOPK)
        e = jnp.take_along_axis(cidx, fi, axis=-1)
        gate = jax.nn.softmax(fv, axis=-1)
        act = jax.nn.gelu(jnp.einsum('thkd,td->thk', tab_u[e], xb, preferred_element_type=F32))
        return jnp.einsum('thk,thkd->td', (gate * act).astype(xb.dtype), tab_v[e])

    return lax.map(block, tok).reshape(b, l, d)


def setup_inputs(seed: int = 0) -> dict:
    key = jax.random.key(seed)
    ks = jax.random.split(key, 24)
    d = D_MODEL

    def nrm(k, shape, s):
        return s * jax.random.normal(k, shape, F32)

    base_decay = np.log(2.0 ** (5 + np.arange(RET_HEADS)) - 1.0).astype(np.float32)
    return {
        'x': nrm(ks[0], (BATCH, SEQ, d), 1.0),
        'c': nrm(ks[1], (BATCH, d), 1.0),
        'ctx': nrm(ks[2], (BATCH, CTX_LEN, d), 1.0),
        'c_ctx': nrm(ks[3], (d,), 1.0),
        'w_mod': nrm(ks[4], (DEPTH, d, 6 * d), 0.5 * d ** -0.5),
        'b_mod': nrm(ks[5], (DEPTH, 6 * d), 0.01),
        'w_in': nrm(ks[6], (DEPTH, d, IN_COLS), d ** -0.5),
        'qk_gain': 1.0 + nrm(ks[7], (DEPTH, 2, HEAD_DIM), 0.05),
        'diff_lambda': nrm(ks[8], (DEPTH, 4, DIFF_DIM), 0.1),
        'diff_subln': 1.0 + nrm(ks[9], (DEPTH, 2 * DIFF_DIM), 0.05),
        'win_sink': nrm(ks[10], (DEPTH, WIN_HEADS), 0.5),
        'ret_decay': jnp.asarray(base_decay) + nrm(ks[11], (DEPTH, 2, RET_HEADS), 0.1),
        'ret_norm': jnp.stack([1.0 + nrm(ks[12], (DEPTH, RET_HEADS * RET_DV), 0.05),
                               nrm(ks[13], (DEPTH, RET_HEADS * RET_DV), 0.02)], axis=1),
        'w_branch': nrm(ks[14], (DEPTH, N_BRANCH, BRANCH_W, d), DEEPNORM_BETA * BRANCH_W ** -0.5),
        'w_out': nrm(ks[15], (DEPTH, d, d), DEEPNORM_BETA * d ** -0.5),
        'ln_attn': jnp.stack([1.0 + nrm(ks[16], (DEPTH, d), 0.05), nrm(ks[17], (DEPTH, d), 0.02)], axis=1),
        'ln_ffn': jnp.stack([1.0 + nrm(ks[18], (DEPTH, d), 0.05), nrm(ks[19], (DEPTH, d), 0.02)], axis=1),
        'peer_wq': nrm(ks[20], (DEPTH, d, PEER_HEADS * 2 * PEER_DQ), d ** -0.5),
        'peer_subkeys': nrm(ks[21], (DEPTH, PEER_HEADS, 2, PEER_NK, PEER_DQ), PEER_DQ ** -0.5),
        'peer_u': nrm(ks[22], (DEPTH, PEER_N, d), d ** -0.5),
        'peer_v': nrm(ks[23], (DEPTH, PEER_N, d), DEEPNORM_BETA),
    }


def reference(x, c, ctx, c_ctx, w_mod, b_mod, w_in, qk_gain, diff_lambda, diff_subln, win_sink,
              ret_decay, ret_norm, w_branch, w_out, ln_attn, ln_ffn, peer_wq, peer_subkeys, peer_u, peer_v):
    b, s, d = x.shape
    n_ctx = ctx.shape[1]
    rows = s // GRID_W
    row = jnp.broadcast_to(jnp.arange(rows, dtype=F32)[:, None], (rows, GRID_W)).reshape(-1)
    col = jnp.broadcast_to(jnp.arange(GRID_W, dtype=F32)[None, :], (rows, GRID_W)).reshape(-1)
    ax64 = axial_tables(row, col, HEAD_DIM)
    ax32 = axial_tables(row, col, DIFF_DIM)
    rope_ctx = rope1d_tables(jnp.arange(n_ctx, dtype=F32), RET_DK)
    rope_lat = rope1d_tables(n_ctx + jnp.arange(s, dtype=F32), RET_DK)
    cond = jax.nn.silu(c)
    cond_ctx = jax.nn.silu(c_ctx)
    h, hc = x, ctx
    for l in range(DEPTH):
        need_ctx = l < DEPTH - 1
        mod = (cond @ w_mod[l] + b_mod[l]).reshape(b, 6, 1, d)
        modc = (cond_ctx @ w_mod[l] + b_mod[l]).reshape(6, d)
        u = h * (1 + mod[:, 1]) + mod[:, 0]
        uc = hc * (1 + modc[1]) + modc[0]
        w_mix = w_in[l, :, :MIX_COLS]
        w_gate = w_in[l, :, MIX_COLS:]
        pl = split_pieces(u @ w_mix)
        pc = split_pieces(uc @ w_mix)
        oa, oac = mixer_gqa(pl[0:3], pc[0:3], qk_gain[l], ax64, need_ctx)
        ob, obc = mixer_diff(pl[3:6], pc[3:6], diff_lambda[l], diff_subln[l], l, ax32, need_ctx)
        oc, occ = mixer_window(pl[6:9], pc[6:9], win_sink[l], ax64, need_ctx)
        od, odc = mixer_retention(pl[9:13], pc[9:13], ret_decay[l], ret_norm[l], rope_lat, rope_ctx, need_ctx)
        y = merge_branches(u, (oa, ob, oc, od), w_gate, w_branch[l], w_out[l])
        h = layer_norm(DEEPNORM_ALPHA * h + mod[:, 2] * y, ln_attn[l])
        if need_ctx:
            yc = merge_branches(uc, (oac, obc, occ, odc), w_gate, w_branch[l], w_out[l])
            hc = layer_norm(DEEPNORM_ALPHA * hc + modc[2] * yc, ln_attn[l])
        u2 = h * (1 + mod[:, 4]) + mod[:, 3]
        y2 = peer_ffn(u2, peer_wq[l], peer_subkeys[l], peer_u[l], peer_v[l])
        h = layer_norm(DEEPNORM_ALPHA * h + mod[:, 5] * y2, ln_ffn[l])
        if need_ctx:
            uc2 = hc * (1 + modc[4]) + modc[3]
            yc2 = peer_ffn(uc2, peer_wq[l], peer_subkeys[l], peer_u[l], peer_v[l])
            hc = layer_norm(DEEPNORM_ALPHA * hc + modc[5] * yc2, ln_ffn[l])
    return h
```

```cpp
#include <hip/hip_runtime.h>
#include <cstdio>
#include <cstdint>

#define GAS __attribute__((address_space(1)))
#define LAS __attribute__((address_space(3)))
typedef unsigned short bf16;
typedef unsigned v4u __attribute__((ext_vector_type(4)));
typedef unsigned v2u __attribute__((ext_vector_type(2)));
typedef float f32x4 __attribute__((ext_vector_type(4)));
typedef float f32x2 __attribute__((ext_vector_type(2)));
typedef float f32x16 __attribute__((ext_vector_type(16)));
typedef short bf16x8 __attribute__((ext_vector_type(8)));
typedef short s16x4 __attribute__((ext_vector_type(4)));

__device__ __forceinline__ unsigned f2bf(float f) { unsigned u = __builtin_bit_cast(unsigned, f); return (u + 0x7fffu + ((u >> 16) & 1u)) >> 16; }
__device__ __forceinline__ unsigned pk2(float lo, float hi) { return f2bf(lo) | (f2bf(hi) << 16); }
__device__ __forceinline__ float bflo(unsigned w) { return __builtin_bit_cast(float, w << 16); }
__device__ __forceinline__ float bfhi(unsigned w) { return __builtin_bit_cast(float, w & 0xffff0000u); }
__device__ __forceinline__ float bf1(bf16 h) { return __builtin_bit_cast(float, ((unsigned)h) << 16); }
__device__ __forceinline__ float ex2(float x) { return __builtin_amdgcn_exp2f(x); }
__device__ __forceinline__ float sigmoidf_(float x) { return __builtin_amdgcn_rcpf(1.f + ex2(-1.4426950408889634f * x)); }
__device__ __forceinline__ int lane_id() { int r; asm volatile("v_mbcnt_lo_u32_b32 %0, -1, 0\n\tv_mbcnt_hi_u32_b32 %0, -1, %0" : "=v"(r)); return r; }
template <int M> __device__ __forceinline__ int lane_xor(int v) {
    if constexpr (M == 1) return __builtin_amdgcn_update_dpp(v, v, 0xB1, 0xf, 0xf, true);
    else if constexpr (M == 2) return __builtin_amdgcn_update_dpp(v, v, 0x4E, 0xf, 0xf, true);
    else if constexpr (M == 4) { const int a = __builtin_amdgcn_update_dpp(v, v, 0x104, 0xf, 0x5, false); return __builtin_amdgcn_update_dpp(a, v, 0x114, 0xf, 0xA, false); }
    else if constexpr (M == 8) return __builtin_amdgcn_update_dpp(v, v, 0x128, 0xf, 0xf, true);
    else if constexpr (M == 16) { auto rr = __builtin_amdgcn_permlane16_swap((unsigned)v, (unsigned)v, false, false); return __builtin_amdgcn_update_dpp((int)rr[1], (int)rr[0], 0xE4, 0xA, 0xf, false); }
    else { static_assert(M == 32, "lane_xor"); auto rr = __builtin_amdgcn_permlane32_swap((unsigned)v, (unsigned)v, false, false); return __builtin_amdgcn_update_dpp((int)rr[1], (int)rr[0], 0xE4, 0xC, 0xf, false); }
}
template <int M> __device__ __forceinline__ float lane_xor(float v) { return __builtin_bit_cast(float, lane_xor<M>(__builtin_bit_cast(int, v))); }
__device__ __forceinline__ float wave_sum(float v) {
    v += lane_xor<1>(v); v += lane_xor<2>(v); v += lane_xor<4>(v); v += lane_xor<8>(v); v += lane_xor<16>(v); v += lane_xor<32>(v);
    return v;
}
__device__ __forceinline__ float wave_max(float v) {
    v = fmaxf(v, lane_xor<1>(v)); v = fmaxf(v, lane_xor<2>(v)); v = fmaxf(v, lane_xor<4>(v)); v = fmaxf(v, lane_xor<8>(v)); v = fmaxf(v, lane_xor<16>(v)); v = fmaxf(v, lane_xor<32>(v));
    return v;
}
__device__ __forceinline__ int opqs(int x) { asm volatile("" : "+s"(x)); return x; }
__device__ __forceinline__ int opq(int x) { asm volatile("" : "+v"(x)); return x; }
__device__ __forceinline__ f32x16 zero16() {
    float z[16];
#pragma unroll
    for (int i = 0; i < 16; i += 4) asm volatile("v_mov_b32 %0, 0\n\tv_mov_b32 %1, 0\n\tv_mov_b32 %2, 0\n\tv_mov_b32 %3, 0" : "=v"(z[i]), "=v"(z[i + 1]), "=v"(z[i + 2]), "=v"(z[i + 3]));
    return (f32x16){z[0], z[1], z[2], z[3], z[4], z[5], z[6], z[7], z[8], z[9], z[10], z[11], z[12], z[13], z[14], z[15]};
}
#define LDS_WAIT() asm volatile("s_waitcnt lgkmcnt(0)" ::: "memory")
#define VM_WAIT() asm volatile("s_waitcnt vmcnt(0)" ::: "memory")

namespace pg8 {
#define PG8_LAS __attribute__((address_space(3)))
typedef unsigned short bf16_t;
typedef short bf16x8 __attribute__((ext_vector_type(8)));
typedef float f32x4 __attribute__((ext_vector_type(4)));
typedef unsigned u32x4 __attribute__((ext_vector_type(4)));
constexpr int BM = 256, BK = 64, HALF = 128, HTB = HALF * BK * 2, STAGE_BYTES = 8 * HTB, NXCD = 8, WGM = 8;
__host__ __device__ __forceinline__ int lds_byte(int r, int c) { const int st = (r >> 4) * 2 + (c >> 5), rr = r & 15, cc = c & 31, ob = rr * 64 + cc * 2; return st * 1024 + (ob ^ (((ob >> 9) & 1) << 5)); }
__host__ __device__ __forceinline__ void stage_rc(int b, int& R, int& C) { const int st = b / 1024, sb = b % 1024, swz = sb ^ (((sb >> 9) & 1) << 5); R = (st >> 1) * 16 + swz / 64; C = (st & 1) * 32 + (swz % 64) / 2; }
__host__ __device__ __forceinline__ int perm32(int rho) { const int n = rho >> 4, i = rho & 15; return 8 * (i >> 2) + 4 * n + (i & 3); }
struct Unit { int pm, pn; };
struct Gemm { const bf16_t* A; const bf16_t* Bt; int M, N, K, lda, ldb; };
struct StaticOrder {
    int nM, nN, nwg, G, c, skip;
    __host__ __device__ void init(int M, int N, int G_, int c_, int skip_ = 0) { skip = skip_; nM = skip_ ? 128 : M / BM; nN = N / BM; nwg = nM * nN; G = G_; c = c_; }
    __host__ __device__ bool next(int i, Unit& u) const {
        const long L = (long)i * G + c; if (L >= nwg) return false;
        int wgid = (int)L; { const int q = nwg / NXCD, r = nwg % NXCD, xcd = wgid % NXCD, off = wgid / NXCD; wgid = (xcd < r ? xcd * (q + 1) : r * (q + 1) + (xcd - r) * q) + off; }
        const int nig = WGM * nN, gid = wgid / nig, fm = gid * WGM, gsz = (nM - fm) < WGM ? (nM - fm) : WGM;
        u.pm = fm + ((wgid % nig) % gsz); u.pn = (wgid % nig) / gsz; if (skip) u.pm += 1 + (u.pm >= 64 ? 1 : 0); return true;
    }
};
__device__ __forceinline__ unsigned cvt_pk_bf16(float lo, float hi) { unsigned r; asm volatile("v_cvt_pk_bf16_f32 %0, %1, %2" : "=v"(r) : "v"(lo), "v"(hi)); return r; }

template <class Epi, class Sched, bool FP8 = false, bool I8 = false>
__device__ __forceinline__ void gemm_phase(PG8_LAS unsigned char* lds, const Gemm g, const Sched& S, const Epi& E, int wid) {
    const int lane = opq(lane_id()), tid = wid * 64 + lane, wr = wid >> 2, wc = wid & 3, fr = lane & 15, fq = lane >> 4;
    const int K = g.K, nt = K / BK;
    unsigned voffA[2], voffB[2];
#pragma unroll
    for (int i = 0; i < 2; ++i) { int R, C; stage_rc(tid * 16 + i * 8192, R, C); const int Rb = Epi::PERM ? ((R & ~31) + perm32(R & 31)) : R;
        voffA[i] = (unsigned)(R * g.lda + C) * 2u; voffB[i] = (unsigned)(Rb * g.ldb + C) * 2u; }
    const size_t kstep = (size_t)(BK * 2);
    const size_t hstepA = (size_t)HALF * g.lda * 2, hstepB = (size_t)HALF * g.ldb * 2;
    const size_t tstepA = 2 * hstepA, tstepB = 2 * hstepB;
    const unsigned ldsw = (unsigned)wid * 1024u;
    const int aoff = lds_byte(wr * 64 + fr, fq * 8), boff = lds_byte(wc * 32 + fr, fq * 8);
#define PG8_SA(b, h) (((b) * 2 + (h)) * HTB)
#define PG8_SB(b, h) ((4 + (b) * 2 + (h)) * HTB)
#define PG8_STAGE(bufoff, gbase, voff) do { _Pragma("unroll") for (int _i = 0; _i < 2; ++_i) { \
        if constexpr (FP8 || I8) {   \
            unsigned keep_; const char* gb_ = (const char*)(gbase); const unsigned la_ = (unsigned)(uintptr_t)(lds + (bufoff) + ldsw + _i * 8192); \
            asm volatile("s_mov_b32 %0, m0\n\ts_mov_b32 m0, %3\n\ts_nop 0\n\tglobal_load_lds_dwordx4 %1, %2\n\ts_mov_b32 m0, %0" : "=&s"(keep_) : "v"((voff)[_i]), "s"(gb_), "s"(la_) : "memory"); } \
        else __builtin_amdgcn_global_load_lds((const unsigned*)((const char*)(gbase) + (voff)[_i]), (PG8_LAS unsigned*)(lds + (bufoff) + ldsw + _i * 8192), 16, 0, 0); } } while (0)
#define PG8_LDA(dst, b, h) do { _Pragma("unroll") for (int m = 0; m < 4; ++m) { const bf16x8 f0_ = *(const PG8_LAS bf16x8*)(lds + PG8_SA(b, h) + aoff + m * 2048), f1_ = *(const PG8_LAS bf16x8*)(lds + PG8_SA(b, h) + aoff + m * 2048 + 1024); \
        dst[m] = __builtin_shufflevector(__builtin_bit_cast(v4i_, f0_), __builtin_bit_cast(v4i_, f1_), 0, 1, 2, 3, 4, 5, 6, 7); } } while (0)
#define PG8_LDB(dst, b, h) do { _Pragma("unroll") for (int n = 0; n < 2; ++n) { const bf16x8 f0_ = *(const PG8_LAS bf16x8*)(lds + PG8_SB(b, h) + boff + n * 2048), f1_ = *(const PG8_LAS bf16x8*)(lds + PG8_SB(b, h) + boff + n * 2048 + 1024); \
        dst[n] = __builtin_shufflevector(__builtin_bit_cast(v4i_, f0_), __builtin_bit_cast(v4i_, f1_), 0, 1, 2, 3, 4, 5, 6, 7); } } while (0)
#define PG8_MMA(ai, bj, At, Bt) do { __builtin_amdgcn_s_setprio(1); _Pragma("unroll") for (int m = 0; m < 4; ++m) _Pragma("unroll") for (int n = 0; n < 2; ++n) { \
        if constexpr (FP8) acc[ai][bj][m][n] = __builtin_amdgcn_mfma_scale_f32_16x16x128_f8f6f4(Bt[n], At[m], acc[ai][bj][m][n], 0, 0, 0, 0, 0, 0); \
        else if constexpr (I8) { v4i_ c_ = __builtin_bit_cast(v4i_, acc[ai][bj][m][n]);   \
               c_ = __builtin_amdgcn_mfma_i32_16x16x64_i8(__builtin_shufflevector(Bt[n], Bt[n], 0, 1, 2, 3), __builtin_shufflevector(At[m], At[m], 0, 1, 2, 3), c_, 0, 0, 0); \
               c_ = __builtin_amdgcn_mfma_i32_16x16x64_i8(__builtin_shufflevector(Bt[n], Bt[n], 4, 5, 6, 7), __builtin_shufflevector(At[m], At[m], 4, 5, 6, 7), c_, 0, 0, 0); \
               acc[ai][bj][m][n] = __builtin_bit_cast(f32x4, c_); } \
        else { acc[ai][bj][m][n] = __builtin_amdgcn_mfma_f32_16x16x32_bf16(__builtin_bit_cast(bf16x8, __builtin_shufflevector(Bt[n], Bt[n], 0, 1, 2, 3)), __builtin_bit_cast(bf16x8, __builtin_shufflevector(At[m], At[m], 0, 1, 2, 3)), acc[ai][bj][m][n], 0, 0, 0); \
               acc[ai][bj][m][n] = __builtin_amdgcn_mfma_f32_16x16x32_bf16(__builtin_bit_cast(bf16x8, __builtin_shufflevector(Bt[n], Bt[n], 4, 5, 6, 7)), __builtin_bit_cast(bf16x8, __builtin_shufflevector(At[m], At[m], 4, 5, 6, 7)), acc[ai][bj][m][n], 0, 0, 0); } } \
        __builtin_amdgcn_s_setprio(0); } while (0)
#define PG8_WAIT_V(n) asm volatile("s_waitcnt vmcnt(" #n ")" ::: "memory")
#define PG8_WAIT_L(n) asm volatile("s_waitcnt lgkmcnt(" #n ")" ::: "memory")
#define PG8_BAR __builtin_amdgcn_s_barrier()
#define PG8_SCHED __builtin_amdgcn_sched_barrier(0)
    Unit cur, nxt; int ui = 0;
    if (!S.next(0, cur)) return;
    f32x4 acc[2][2][4][2];
#define PG8_ZERO_ACC() do { _Pragma("unroll") for (int a = 0; a < 2; ++a) _Pragma("unroll") for (int b = 0; b < 2; ++b) _Pragma("unroll") for (int m = 0; m < 4; ++m) _Pragma("unroll") for (int n = 0; n < 2; ++n) { \
        float z0, z1, z2, z3; asm volatile("v_mov_b32 %0, 0\n\tv_mov_b32 %1, 0\n\tv_mov_b32 %2, 0\n\tv_mov_b32 %3, 0" : "=v"(z0), "=v"(z1), "=v"(z2), "=v"(z3)); acc[a][b][m][n] = (f32x4){z0, z1, z2, z3}; } } while (0)
    PG8_ZERO_ACC();
    typedef int v4i_ __attribute__((ext_vector_type(4))); typedef int v8i_ __attribute__((ext_vector_type(8)));
    v8i_ At[4], B0[2], B1[2];
    const char* cA = (const char*)g.A + (size_t)cur.pm * tstepA; const char* cB = (const char*)g.Bt + (size_t)cur.pn * tstepB;
    PG8_STAGE(PG8_SB(0, 0), cB, voffB); PG8_STAGE(PG8_SB(0, 1), cB + hstepB, voffB); PG8_STAGE(PG8_SA(0, 0), cA, voffA); PG8_STAGE(PG8_SA(0, 1), cA + hstepA, voffA);
    if (wr == 1) PG8_BAR;
    PG8_WAIT_V(2); PG8_BAR;
    PG8_STAGE(PG8_SB(1, 0), cB + kstep, voffB); PG8_STAGE(PG8_SA(1, 0), cA + kstep, voffA); PG8_STAGE(PG8_SB(1, 1), cB + hstepB + kstep, voffB);
    PG8_WAIT_V(6); PG8_BAR;
    for (;;) {
        const bool has_next = S.next(ui + 1, nxt);
        const char* nA = has_next ? (const char*)g.A + (size_t)nxt.pm * tstepA : cA; const char* nB = has_next ? (const char*)g.Bt + (size_t)nxt.pn * tstepB : cB;
#pragma unroll 1
        for (int t = 0; t < nt; t += 2) {
            const bool last = (t == nt - 2);
            const char* a1 = cA + (size_t)(t + 1) * kstep;
            const char* a2 = last ? nA : cA + (size_t)(t + 2) * kstep; const char* b2 = last ? nB : cB + (size_t)(t + 2) * kstep;
            const char* a3 = a2 + kstep; const char* b3 = b2 + kstep;
            PG8_LDB(B0, 0, 0); PG8_LDB(B1, 0, 1); PG8_SCHED; PG8_LDA(At, 0, 0); PG8_STAGE(PG8_SA(1, 1), a1 + hstepA, voffA);
            PG8_WAIT_V(8); PG8_WAIT_L(0); PG8_BAR; PG8_MMA(0, 0, At, B0); PG8_MMA(0, 1, At, B1); PG8_BAR; PG8_SCHED;
            PG8_LDA(At, 0, 1); PG8_STAGE(PG8_SB(0, 0), b2, voffB); PG8_STAGE(PG8_SB(0, 1), b2 + hstepB, voffB); PG8_STAGE(PG8_SA(0, 0), a2, voffA);
            PG8_WAIT_V(8); PG8_WAIT_L(0); PG8_BAR; PG8_MMA(1, 0, At, B0); PG8_MMA(1, 1, At, B1); PG8_BAR; PG8_SCHED;
            PG8_LDB(B0, 1, 0); PG8_LDB(B1, 1, 1); PG8_SCHED; PG8_LDA(At, 1, 0); PG8_STAGE(PG8_SA(0, 1), a2 + hstepA, voffA);
            PG8_WAIT_V(8); PG8_WAIT_L(0); PG8_BAR; PG8_MMA(0, 0, At, B0); PG8_MMA(0, 1, At, B1); PG8_BAR; PG8_SCHED;
            PG8_LDA(At, 1, 1); PG8_STAGE(PG8_SB(1, 0), b3, voffB); PG8_STAGE(PG8_SB(1, 1), b3 + hstepB, voffB); PG8_STAGE(PG8_SA(1, 0), a3, voffA);
            PG8_WAIT_V(8); PG8_WAIT_L(0); PG8_BAR; PG8_MMA(1, 0, At, B0); PG8_MMA(1, 1, At, B1); PG8_BAR; PG8_SCHED;
        }
        if (wr == 0) PG8_BAR;
        E(acc, cur, wr, wc, fr, fq);
        if (!has_next) break;
        PG8_ZERO_ACC();
        cur = nxt; cA = nA; cB = nB; ++ui;
        if (wr == 1) PG8_BAR;
    }
    PG8_WAIT_V(0);
    PG8_BAR;
#undef PG8_ZERO_ACC
#undef PG8_SA
#undef PG8_SB
#undef PG8_STAGE
#undef PG8_LDA
#undef PG8_LDB
#undef PG8_MMA
#undef PG8_WAIT_V
#undef PG8_WAIT_L
#undef PG8_BAR
#undef PG8_SCHED
}
}
#define XB_TMO      128
#define XB_XCNT(j)  (256  + 64 * (j))
#define XB_XSUB(j)  (1280 + 64 * (j))
#define XB_XGEN(j)  (2304 + 64 * (j))
#define XB_TOP      3328
#define XB_TOPGEN   3392
#define XCD_BAR_WORDS 3456
#define XB_SPIN_CAP (1u << 18)
__device__ __forceinline__ unsigned xb_ld(unsigned* p)              { return __hip_atomic_load(p, __ATOMIC_RELAXED, __HIP_MEMORY_SCOPE_AGENT); }
__device__ __forceinline__ unsigned xb_add(unsigned* p, unsigned v) { return __hip_atomic_fetch_add(p, v, __ATOMIC_RELAXED, __HIP_MEMORY_SCOPE_AGENT); }
__device__ __forceinline__ unsigned xb_xcc_id() { return (unsigned)__builtin_amdgcn_s_getreg((3 << 11) | 20) & 0xFu; }
#define XB_SPIN(cond, bar) do { unsigned _sp = 0; while (cond) { __builtin_amdgcn_s_sleep(1); \
    if ((++_sp & 255u) == 0u) { if (xb_ld(&(bar)[XB_TMO])) break; if (_sp > XB_SPIN_CAP) { atomicAdd(&(bar)[XB_TMO], 1u); break; } } } } while (0)
struct XcdBarrier { unsigned* bar; unsigned x; volatile LAS unsigned* st; unsigned w0; };
__device__ __forceinline__ XcdBarrier xcd_barrier_post(unsigned* bar, volatile LAS unsigned* st) {
    XcdBarrier b; b.bar = bar; b.x = xb_xcc_id(); b.st = st; b.w0 = 0u;
    if (threadIdx.x == 0) (void)xb_add(&bar[XB_XCNT(b.x)], 1u);
    return b;
}
__device__ __forceinline__ void xcd_barrier_complete(unsigned* bar, unsigned x, unsigned& nloc, unsigned& nx) {
    const unsigned G = gridDim.x * gridDim.y * gridDim.z;
    unsigned sum, cnt, mine, sp = 0u;
    for (;;) {
        sum = 0u; cnt = 0u; mine = 0u;
#pragma unroll
        for (unsigned j = 0; j < 16; ++j) { const unsigned c = xb_ld(&bar[XB_XCNT(j)]); sum += c; cnt += (c > 0u) ? 1u : 0u; mine = (j == x) ? c : mine; }
        if (sum == G) break;
        __builtin_amdgcn_s_sleep(1);
        if ((++sp & 255u) == 0u) { if (xb_ld(&bar[XB_TMO])) break; if (sp > XB_SPIN_CAP) { atomicAdd(&bar[XB_TMO], 1u); break; } }
    }
    nloc = mine > 0u ? mine : 1u; nx = cnt > 0u ? cnt : 1u;
}
__device__ __forceinline__ void xcd_barrier(const XcdBarrier& b) {
    asm volatile("s_waitcnt vmcnt(0)" ::: "memory");
    __syncthreads();
    if (b.w0 && lane_id() == 0) {
        unsigned* bar = b.bar; asm volatile("" : "+s"(bar));
        __builtin_amdgcn_s_waitcnt(0);
        unsigned nloc = b.st[0], nx = b.st[1];
        if (nloc == 0u) { xcd_barrier_complete(bar, b.x, nloc, nx); b.st[0] = nloc; b.st[1] = nx; }
        const unsigned old = xb_add(&bar[XB_XSUB(b.x)], 1u);
        const unsigned gen = old / nloc;
        if (old + 1u == (gen + 1u) * nloc) {
            __builtin_amdgcn_fence(__ATOMIC_RELEASE, "agent");
            asm volatile("s_waitcnt vmcnt(0)" ::: "memory");
            const unsigned og = xb_add(&bar[XB_TOP], 1u);
            const unsigned tg = og / nx;
            if (og + 1u == (tg + 1u) * nx) xb_add(&bar[XB_TOPGEN], 1u);
            else XB_SPIN(xb_ld(&bar[XB_TOPGEN]) == tg, bar);
            __builtin_amdgcn_fence(__ATOMIC_ACQUIRE, "agent");
            xb_add(&bar[XB_XGEN(b.x)], 1u);
            asm volatile("s_waitcnt vmcnt(0)" ::: "memory");
        } else {
            XB_SPIN(xb_ld(&bar[XB_XGEN(b.x)]) == gen, bar);
            __builtin_amdgcn_fence(__ATOMIC_ACQUIRE, "agent");
            asm volatile("s_waitcnt vmcnt(0)" ::: "memory");
        }
    }
    __syncthreads();
}

namespace attn_body {
using u32x4=__attribute__((ext_vector_type(4)))unsigned;
constexpr int NW=8,QBLK=32,QB=QBLK*NW,KVBLK=64,QK8P=384,VTP=16640;
__device__ __forceinline__ int crow(int r,int hi){return (r&3)+8*(r>>2)+4*hi;}
#define SBAR() __builtin_amdgcn_sched_barrier(0)
constexpr int NSLOT=3, SLOTB=8192;
constexpr int LDS_K=0, LDS_V=NSLOT*SLOTB, LDS_WS=2*NSLOT*SLOTB, LDS_OST=LDS_WS+NW*64*4, LDS_BYTES=LDS_OST+2*NW*4096;
__device__ __forceinline__ void glds16(const void*gsrc,unsigned lds_dst){unsigned keep;
  asm volatile("s_mov_b32 %0, m0\n\ts_mov_b32 m0, %2\n\ts_nop 0\n\tglobal_load_lds_dwordx4 %1, off\n\ts_mov_b32 m0, %0":"=&s"(keep):"v"(gsrc),"s"(lds_dst):"memory");}
__device__ __forceinline__ float max3f(float a,float b,float c){float r;asm("v_max3_f32 %0, %1, %2, %3":"=v"(r):"v"(a),"v"(b),"v"(c));return r;}
__device__ __forceinline__ float max2f(float a,float b){float r;asm("v_max_f32_e32 %0, %1, %2":"=v"(r):"v"(a),"v"(b));return r;}
__device__ __forceinline__ float fadd_s(float a,float b){float r;asm("v_add_f32_e32 %0, %1, %2":"=v"(r):"v"(a),"v"(b));return r;}
__device__ __forceinline__ float fsub_s(float a,float b){float r;asm("v_sub_f32_e32 %0, %1, %2":"=v"(r):"v"(a),"v"(b));return r;}
typedef float f32x2_t __attribute__((ext_vector_type(2))); typedef __bf16 bf16x2_t __attribute__((ext_vector_type(2)));
__device__ __forceinline__ unsigned cvtpk_s(float lo,float hi){f32x2_t v={lo,hi};bf16x2_t b=__builtin_convertvector(v,bf16x2_t);return __builtin_bit_cast(unsigned,b);}
#define WAIT_BAR(N) asm volatile("s_waitcnt vmcnt(" #N ") lgkmcnt(0)\n\ts_barrier":::"memory")

typedef __attribute__((address_space(3))) const char* lds_cptr;
template<int ND0=4> __device__ __forceinline__ void qkt(f32x16&p0,f32x16&p1,lds_cptr Kslot,const bf16x8*qr,const f32x16&negm,int r32,int hi){
  const lds_cptr kb=Kslot+hi*1024+r32*16;
  #pragma unroll
  for(int d0=0;d0<ND0;++d0){
    const bf16x8 b0=*(const __attribute__((address_space(3))) bf16x8*)(kb+d0*2048);
    const bf16x8 b1=*(const __attribute__((address_space(3))) bf16x8*)(kb+d0*2048+512);
    if(d0==0){p0=__builtin_amdgcn_mfma_f32_32x32x16_bf16(b0,qr[0],negm,0,0,0);p1=__builtin_amdgcn_mfma_f32_32x32x16_bf16(b1,qr[0],negm,0,0,0);}
    else{p0=__builtin_amdgcn_mfma_f32_32x32x16_bf16(b0,qr[d0],p0,0,0,0);p1=__builtin_amdgcn_mfma_f32_32x32x16_bf16(b1,qr[d0],p1,0,0,0);}}
}
typedef int v8i_t __attribute__((ext_vector_type(8))); typedef int v4i_t __attribute__((ext_vector_type(4)));
__device__ __forceinline__ v8i_t kload8q(lds_cptr kp){ const v4i_t a=*(const __attribute__((address_space(3))) v4i_t*)(kp), c=*(const __attribute__((address_space(3))) v4i_t*)(kp+1024); return __builtin_shufflevector(a,c,0,1,2,3,4,5,6,7); }
__device__ __forceinline__ void qkt8(f32x16&p0,f32x16&p1,lds_cptr Kslot,const v8i_t qr8,const f32x16&negm,int r32,int hi){
  const lds_cptr kb=Kslot+hi*2048+r32*16;
  p0=__builtin_amdgcn_mfma_scale_f32_32x32x64_f8f6f4(kload8q(kb),qr8,negm,0,0,0,0,0,0);
  p1=__builtin_amdgcn_mfma_scale_f32_32x32x64_f8f6f4(kload8q(kb+512),qr8,negm,0,0,0,0,0,0);
}
typedef short v4i16_t __attribute__((ext_vector_type(4)));
__device__ __forceinline__ void kload8(bf16x8*kf,lds_cptr kp){
  kf[0]=*(const __attribute__((address_space(3))) bf16x8*)(kp);      kf[1]=*(const __attribute__((address_space(3))) bf16x8*)(kp+512);
  kf[2]=*(const __attribute__((address_space(3))) bf16x8*)(kp+2048); kf[3]=*(const __attribute__((address_space(3))) bf16x8*)(kp+2560);
  kf[4]=*(const __attribute__((address_space(3))) bf16x8*)(kp+4096); kf[5]=*(const __attribute__((address_space(3))) bf16x8*)(kp+4608);
  kf[6]=*(const __attribute__((address_space(3))) bf16x8*)(kp+6144); kf[7]=*(const __attribute__((address_space(3))) bf16x8*)(kp+6656);
}
__device__ __forceinline__ void kload2(bf16x8*kf,lds_cptr kp,int j){ kf[2*j]=*(const __attribute__((address_space(3))) bf16x8*)(kp+j*2048); kf[2*j+1]=*(const __attribute__((address_space(3))) bf16x8*)(kp+j*2048+512); }
__device__ __forceinline__ s16x4 vtr(lds_cptr p){ return __builtin_bit_cast(s16x4,__builtin_amdgcn_ds_read_tr16_b64_v4i16((__attribute__((address_space(3))) v4i16_t*)p)); }
__device__ __forceinline__ float rowmax(const f32x16&p0,const f32x16&p1){
  float a=max3f(p0[0],p0[1],p1[0]),b=max3f(p0[2],p0[3],p1[1]);a=max3f(a,p1[2],p1[3]);
  #pragma unroll
  for(int r=4;r<16;r+=4){a=max3f(a,p0[r],p0[r+1]);b=max3f(b,p0[r+2],p0[r+3]);a=max3f(a,p1[r],p1[r+1]);b=max3f(b,p1[r+2],p1[r+3]);}
  const float m=max2f(a,b);
  auto rr=__builtin_amdgcn_permlane32_swap(__float_as_uint(m),__float_as_uint(m),false,false);
  return max2f(__uint_as_float(rr[0]),__uint_as_float(rr[1]));
}
__device__ __forceinline__ void pv(f32x16*o,int vb,bf16x8 pa0,bf16x8 pa1,bf16x8 pa2,bf16x8 pa3){
  #pragma unroll
  for(int d0=0;d0<2;++d0){s16x4 lo[4],hi[4];
    #pragma unroll
    for(int ks=0;ks<4;++ks){
      asm volatile("ds_read_b64_tr_b16 %0,%1 offset:%c2":"=&v"(lo[ks]):"v"(vb),"i"(d0*4096+ks*1024):"memory");
      asm volatile("ds_read_b64_tr_b16 %0,%1 offset:%c2":"=&v"(hi[ks]):"v"(vb),"i"(d0*4096+ks*1024+512):"memory");}
    asm volatile("s_waitcnt lgkmcnt(0)":::"memory");SBAR();
    #define PK(k) (bf16x8){lo[k][0],lo[k][1],lo[k][2],lo[k][3],hi[k][0],hi[k][1],hi[k][2],hi[k][3]}
    o[d0]=__builtin_amdgcn_mfma_f32_32x32x16_bf16(pa0,PK(0),o[d0],0,0,0);
    o[d0]=__builtin_amdgcn_mfma_f32_32x32x16_bf16(pa1,PK(1),o[d0],0,0,0);
    o[d0]=__builtin_amdgcn_mfma_f32_32x32x16_bf16(pa2,PK(2),o[d0],0,0,0);
    o[d0]=__builtin_amdgcn_mfma_f32_32x32x16_bf16(pa3,PK(3),o[d0],0,0,0);
    #undef PK
  }
}
__device__ __forceinline__ void wmask(f32x16&p0,f32x16&p1,int ts,int qlat,int hi){
  if(ts>=4){ const float NEG=-INFINITY; const int kb=64*(ts-4)+4*hi-qlat;
    #pragma unroll
    for(int r=0;r<16;++r){const int d=kb+(r&3)+8*(r>>2); if(d>128||d<-128)p0[r]=NEG; if(d+32>128||d+32<-128)p1[r]=NEG;} }
}

template<int THRL,bool D32,bool WIN,bool Q8=false> __device__ __forceinline__ void attn_core(const bf16*Qu,int qpitch,const bf16*__restrict__ Kh,const bf16*__restrict__ Vh,int kvp,int NT,int woff,int q0lat,int win,float kmax,float sk2,int ost,char*shm,int wid,const unsigned char*Q8u=nullptr,const unsigned char*K8h=nullptr,const unsigned char*V8Th=nullptr,int q8p=QK8P,int qmask=-1){
  const int lane=opq(lane_id()),r32=lane&31,hi=lane>>5;
  if(wid>=4)__builtin_amdgcn_s_setprio(1);
  const bf16*Qw=Qu+(long)(wid*QBLK)*qpitch;
  const unsigned lds0=(unsigned)(uintptr_t)shm;
  float*wsf=(float*)(shm+LDS_WS)+wid*64;
  const char*ksrc=Q8?(const char*)K8h+(long)lane*q8p+wid*16:(const char*)(Kh+(long)lane*kvp+wid*8); const long kstp=Q8?(long)KVBLK*q8p:(long)KVBLK*kvp*2;
  const bf16*vsrc=Vh+(long)(16*(wid&3)+(lane>>2))*kvp+(wid>>2)*32+(lane&3)*8;
  const unsigned char*vsrc8=V8Th+(long)lane*VTP+((wid&3)*16);
  const unsigned kdst=lds0+LDS_K+wid*1024, vdst=lds0+LDS_V+wid*1024;
  #define TM(t) ((t)+(((t)>=4)?woff:0))
  const bool kdma=!(D32||Q8)||wid<4;
  #define DMA_K(t,slot) do{ if(kdma) glds16(ksrc+(long)TM(t)*kstp,(unsigned)__builtin_amdgcn_readfirstlane(kdst+(slot))); }while(0)
  #define DMA_V(t,slot) do{ if constexpr(Q8){ if(!kdma) glds16(vsrc8+(long)TM(t)*KVBLK,(unsigned)__builtin_amdgcn_readfirstlane(lds0+LDS_V+(wid&3)*1024+(slot))); } else glds16(vsrc+(long)TM(t)*KVBLK*kvp,(unsigned)__builtin_amdgcn_readfirstlane(vdst+(slot))); }while(0)
  const int vb0=(int)(lds0+LDS_V)+((lane>>4)&1)*32+(lane&3)*8+(4*hi+((lane&15)>>2))*64;
  bf16x8 kf[8]; v8i_t kf8[2]; v8i_t qr8;
  const lds_cptr shm3=(lds_cptr)shm; const lds_cptr kq0=shm3+LDS_K+hi*2048+r32*16; const lds_cptr vq0=shm3+LDS_V+hi*2048+r32*16; const lds_cptr kp0=shm3+LDS_K+hi*1024+r32*16; const lds_cptr vp0=shm3+LDS_V+((lane>>4)&1)*32+(lane&3)*8+(4*hi+((lane&15)>>2))*64;
  DMA_K(0,0);DMA_V(0,0);DMA_K(1,SLOTB);
  bf16x8 qr[4];
  if constexpr(Q8){ const unsigned char*qp=Q8u+(long)(wid*QBLK+r32)*q8p+32*hi; const v4i_t a=*(const v4i_t*)qp, c=*(const v4i_t*)(qp+16); qr8=__builtin_shufflevector(a,c,0,1,2,3,4,5,6,7);
    if(qmask>=0&&hi!=qmask)qr8=v8i_t{};
    qr[0]=bf16x8{};qr[1]=bf16x8{};qr[2]=bf16x8{};qr[3]=bf16x8{}; }
  else {
  #pragma unroll
  for(int d0=0;d0<(D32?2:4);++d0)qr[d0]=*reinterpret_cast<const bf16x8*>(&Qw[(long)r32*qpitch+d0*16+hi*8]);
  if constexpr(D32){qr[2]=bf16x8{};qr[3]=bf16x8{};} qr8=v8i_t{}; }
  float qn2=0.f;
  if constexpr(Q8){
    #pragma unroll
    for(int j=0;j<8;++j){ const f32x2_t lo=__builtin_amdgcn_cvt_pk_f32_fp8(qr8[j],false), hh=__builtin_amdgcn_cvt_pk_f32_fp8(qr8[j],true); qn2+=lo[0]*lo[0]+lo[1]*lo[1]+hh[0]*hh[0]+hh[1]*hh[1]; } }
  else
  #pragma unroll
  for(int d0=0;d0<(D32?2:4);++d0){ const u32x4 qq=__builtin_bit_cast(u32x4,qr[d0]);
    #pragma unroll
    for(int j=0;j<4;++j){ const float a=bflo(qq[j]),c=bfhi(qq[j]); qn2+=a*a+c*c; } }
  {auto rr=__builtin_amdgcn_permlane32_swap(__float_as_uint(qn2),__float_as_uint(qn2),false,false);qn2=__uint_as_float(rr[0])+__uint_as_float(rr[1]);}
  const float mhat=__builtin_sqrtf(qn2)*kmax*1.001f+0.05f;
  float l_reg=0.f;f32x16 o[2];o[0]=zero16();o[1]=zero16();f32x16 negm;
  #pragma unroll
  for(int r=0;r<16;++r)negm[r]=Q8?12.f-mhat:-mhat;
  asm volatile("":"+v"(negm));
  const int qlat=q0lat+wid*QBLK+r32;
  #define CMASK(P0,P1,t) do{ if constexpr(WIN){ wmask(P0,P1,TM(t),qlat,hi); } }while(0)
  f32x16 pA0,pA1,pB0,pB1;
  int sl_prev=0,sl_cur=0,sl_next=SLOTB;
  #define ROT() do{sl_prev=sl_cur;sl_cur=sl_next;sl_next=(sl_next==(NSLOT-1)*SLOTB)?0:sl_next+SLOTB;}while(0)
  DMA_K(2,2*SLOTB);
  if constexpr(Q8){WAIT_BAR(2);}else{WAIT_BAR(3);}
  if constexpr(Q8) qkt8(pA0,pA1,shm3+LDS_K,qr8,negm,r32,hi); else qkt<(D32?2:4)>(pA0,pA1,shm3+LDS_K,qr,negm,r32,hi);
  asm volatile("s_nop 15\n\ts_nop 7":"+v"(pA0),"+v"(pA1));CMASK(pA0,pA1,0);
  _Pragma("unroll") for(int r=0;r<16;++r){pA0[r]=__builtin_amdgcn_exp2f(pA0[r]);pA1[r]=__builtin_amdgcn_exp2f(pA1[r]);}
  WAIT_BAR(0);
  DMA_K(3,0);DMA_V(1,SLOTB);
  ROT();
  if constexpr(Q8){kf8[0]=kload8q(kq0+sl_cur);kf8[1]=kload8q(kq0+sl_cur+512);} else if constexpr(D32){kload2(kf,kp0+sl_cur,0);kload2(kf,kp0+sl_cur,1);} else kload8(kf,kp0+sl_cur);
  WAIT_BAR(2);
  s16x4 vlo[8],vhi[8]; u32x4 pw0,pw1,pw2,pw3;
  #define PKW(P,B) cvtpk_s(P[B],P[B+1])
  #define PAF(k) __builtin_bit_cast(bf16x8,pw##k)
  #define VFR(i) (bf16x8){vlo[i][0],vlo[i][1],vlo[i][2],vlo[i][3],vhi[i][0],vhi[i][1],vhi[i][2],vhi[i][3]}
  #define PIN(x) asm volatile("":"+v"(x))
  #define MX3(a,b,c) __builtin_fmaxf(__builtin_fmaxf((a),(b)),(c))
  #define GAPA(MF,A0,A1,A2,A3,W0,W1,PW) do{ MF; sacc+=A0; sacc+=A1; sacc+=A2; sacc+=A3; PIN(sacc); W0; W1; PIN(PW); SBAR(); }while(0)
  #define EX(v) __builtin_amdgcn_exp2f(v)
  #define GAPB(MF,X,B) do{ MF; X[B]=EX(X[B]); X[B+1]=EX(X[B+1]); X[B+2]=EX(X[B+2]); X[B+3]=EX(X[B+3]); PIN(X); SBAR(); }while(0)
  #define VRD(i) do{ vlo[i]=vtr(vp_+(((i)>>2)*4096+((i)&3)*1024)); vhi[i]=vtr(vp_+(((i)>>2)*4096+((i)&3)*1024+512)); }while(0)
  #define KRD(G,j) do{ if constexpr(Q8){ if(G && (j)<2){ kf8[(j)&1]=kload8q(kq0+sl_next+((j)&1)*512); SBAR(); } } else if(G && !(D32 && (j)>=2)){ kload2(kf,kp0+sl_next,j); SBAR(); } }while(0)
  #define MF8(j) __builtin_amdgcn_mfma_scale_f32_32x32x64_f8f6f4(kf8[j],qr8,negm,0,0,0,0,0,0)
  #define STEP(C0,C1,P0,P1,t,GK,GV,GL) do{ SBAR(); \
    const lds_cptr vp_=vp0+sl_prev; \
    VRD(0); SBAR(); float sacc=(P0[0]+P0[1]); \
    GAPA(if constexpr(Q8) C0=MF8(0); else C0=__builtin_amdgcn_mfma_f32_32x32x16_bf16(kf[0],qr[0],negm,0,0,0), P0[2],P0[3],P0[4],P0[5],     pw0[0]=PKW(P0,0), pw0[1]=PKW(P0,2), pw0); \
    VRD(4); SBAR(); GAPA(if constexpr(!Q8) C1=__builtin_amdgcn_mfma_f32_32x32x16_bf16(kf[1],qr[0],negm,0,0,0), P0[6],P0[7],P0[8],P0[9],     pw0[2]=PKW(P0,4), pw0[3]=PKW(P0,6), pw0); \
    VRD(1); SBAR(); GAPA(if constexpr(!Q8) C0=__builtin_amdgcn_mfma_f32_32x32x16_bf16(kf[2],qr[1],C0,0,0,0),   P0[10],P0[11],P0[12],P0[13], pw1[0]=PKW(P0,8), pw1[1]=PKW(P0,10), pw1); \
    VRD(5); SBAR(); GAPA(if constexpr(!Q8) C1=__builtin_amdgcn_mfma_f32_32x32x16_bf16(kf[3],qr[1],C1,0,0,0),   P0[14],P0[15],P1[0],P1[1],   pw1[2]=PKW(P0,12),pw1[3]=PKW(P0,14), pw1); \
    VRD(2); SBAR(); GAPA(if constexpr(Q8) C1=MF8(1); else if constexpr(!D32) C0=__builtin_amdgcn_mfma_f32_32x32x16_bf16(kf[4],qr[2],C0,0,0,0),   P1[2],P1[3],P1[4],P1[5],     pw2[0]=PKW(P1,0), pw2[1]=PKW(P1,2), pw2); \
    VRD(6); SBAR(); GAPA(if constexpr(!D32&&!Q8) C1=__builtin_amdgcn_mfma_f32_32x32x16_bf16(kf[5],qr[2],C1,0,0,0),   P1[6],P1[7],P1[8],P1[9],     pw2[2]=PKW(P1,4), pw2[3]=PKW(P1,6), pw2); \
    VRD(3); SBAR(); GAPA(if constexpr(!D32&&!Q8) C0=__builtin_amdgcn_mfma_f32_32x32x16_bf16(kf[6],qr[3],C0,0,0,0),   P1[10],P1[11],P1[12],P1[13], pw3[0]=PKW(P1,8), pw3[1]=PKW(P1,10), pw3); \
    VRD(7); SBAR(); GAPA(if constexpr(!D32&&!Q8) C1=__builtin_amdgcn_mfma_f32_32x32x16_bf16(kf[7],qr[3],C1,0,0,0),   P1[14],P1[15],0.f,0.f,       pw3[2]=PKW(P1,12),pw3[3]=PKW(P1,14), pw3); \
    l_reg+=sacc; \
    if(GK){DMA_K((t)+3,sl_cur);} if(GV){DMA_V((t)+1,sl_next);} \
    CMASK(C0,C1,t); \
    SBAR(); \
    GAPB(o[0]=__builtin_amdgcn_mfma_f32_32x32x16_bf16(PAF(0),VFR(0),o[0],0,0,0), C0,0); \
    GAPB(o[1]=__builtin_amdgcn_mfma_f32_32x32x16_bf16(PAF(0),VFR(4),o[1],0,0,0), C0,4); \
    KRD(GL,0); GAPB(o[0]=__builtin_amdgcn_mfma_f32_32x32x16_bf16(PAF(1),VFR(1),o[0],0,0,0), C0,8); \
    KRD(GL,1); GAPB(o[1]=__builtin_amdgcn_mfma_f32_32x32x16_bf16(PAF(1),VFR(5),o[1],0,0,0), C0,12); \
    KRD(GL,2); GAPB(o[0]=__builtin_amdgcn_mfma_f32_32x32x16_bf16(PAF(2),VFR(2),o[0],0,0,0), C1,0); \
    KRD(GL,3); GAPB(o[1]=__builtin_amdgcn_mfma_f32_32x32x16_bf16(PAF(2),VFR(6),o[1],0,0,0), C1,4); \
    GAPB(o[0]=__builtin_amdgcn_mfma_f32_32x32x16_bf16(PAF(3),VFR(3),o[0],0,0,0), C1,8); \
    GAPB(o[1]=__builtin_amdgcn_mfma_f32_32x32x16_bf16(PAF(3),VFR(7),o[1],0,0,0), C1,12); \
    }while(0)
  v8i_t vf8[2]; int p8[8]; f32x16 lacc=zero16(); v8i_t ones8; { int o0_,o1_,o2_,o3_,o4_,o5_,o6_,o7_; asm volatile("v_mov_b32 %0, 0x38383838\n\tv_mov_b32 %1, 0x38383838\n\tv_mov_b32 %2, 0x38383838\n\tv_mov_b32 %3, 0x38383838\n\tv_mov_b32 %4, 0x38383838\n\tv_mov_b32 %5, 0x38383838\n\tv_mov_b32 %6, 0x38383838\n\tv_mov_b32 %7, 0x38383838":"=v"(o0_),"=v"(o1_),"=v"(o2_),"=v"(o3_),"=v"(o4_),"=v"(o5_),"=v"(o6_),"=v"(o7_)); ones8=(v8i_t){o0_,o1_,o2_,o3_,o4_,o5_,o6_,o7_}; }
  #define PK8(P,B) __builtin_amdgcn_cvt_pk_bf8_f32(P[(B)+2],P[(B)+3],__builtin_amdgcn_cvt_pk_bf8_f32(P[B],P[(B)+1],0,false),true)
  #define P8V (v8i_t){p8[0],p8[1],p8[2],p8[3],p8[4],p8[5],p8[6],p8[7]}
  #define MFPV(d0) o[d0]=__builtin_amdgcn_mfma_scale_f32_32x32x64_f8f6f4(P8V,vf8[d0],o[d0],1,0,0,0,0,0)
  #define GAPQ(MF,A0,A1,A2,A3,W,PWI) do{ MF; W; PIN(p8[PWI]); SBAR(); }while(0)
  #define MFL() lacc=__builtin_amdgcn_mfma_scale_f32_32x32x64_f8f6f4(P8V,ones8,lacc,1,0,0,0,0,0)
  #define STEP8(C0,C1,P0,P1,t,GK,GV,GL) do{ SBAR(); \
    const lds_cptr vq_=vq0+sl_prev; \
    vf8[0]=kload8q(vq_); SBAR(); \
    GAPQ(C0=MF8(0), P0[2],P0[3],P0[4],P0[5],     p8[0]=PK8(P0,0), 0); \
    vf8[1]=kload8q(vq_+512); SBAR(); \
    GAPQ((void)0,   P0[6],P0[7],P0[8],P0[9],     p8[1]=PK8(P0,4), 1); \
    GAPQ((void)0,   P0[10],P0[11],P0[12],P0[13], p8[2]=PK8(P0,8), 2); \
    GAPQ((void)0,   P0[14],P0[15],P1[0],P1[1],   p8[3]=PK8(P0,12),3); \
    GAPQ(C1=MF8(1), P1[2],P1[3],P1[4],P1[5],     p8[4]=PK8(P1,0), 4); \
    GAPQ((void)0,   P1[6],P1[7],P1[8],P1[9],     p8[5]=PK8(P1,4), 5); \
    GAPQ((void)0,   P1[10],P1[11],P1[12],P1[13], p8[6]=PK8(P1,8), 6); \
    GAPQ((void)0,   P1[14],P1[15],0.f,0.f,       p8[7]=PK8(P1,12),7); \
    if(GK){DMA_K((t)+3,sl_cur);} if(GV){DMA_V((t)+1,sl_next);} \
    SBAR(); \
    GAPB(MFPV(0), C0,0); \
    GAPB(MFL(), C0,4); \
    KRD(GL,0); GAPB((void)0, C0,8); \
    KRD(GL,1); GAPB((void)0, C0,12); \
    GAPB(MFPV(1), C1,0); \
    GAPB((void)0, C1,4); \
    GAPB((void)0, C1,8); \
    GAPB((void)0, C1,12); \
    }while(0)
  int t=1;
  if constexpr(Q8){
  for(;t+5<NT;t+=2){
    STEP8(pB0,pB1,pA0,pA1,t,true,true,true);     WAIT_BAR(1); ROT();
    STEP8(pA0,pA1,pB0,pB1,t+1,true,true,true);   WAIT_BAR(1); ROT();
  }
  for(;t+1<NT;t+=2){
    STEP8(pB0,pB1,pA0,pA1,t,(t+3<NT),(t+1<NT),(t+1<NT));       WAIT_BAR(0); ROT();
    STEP8(pA0,pA1,pB0,pB1,t+1,(t+4<NT),(t+2<NT),(t+2<NT));     WAIT_BAR(0); ROT();
  }
  STEP8(pB0,pB1,pA0,pA1,NT-1,false,false,false);
  { _Pragma("unroll") for(int i=0;i<4;++i){p8[i]=PK8(pB0,4*i);p8[4+i]=PK8(pB1,4*i);}
    vf8[0]=kload8q(vq0+sl_cur);vf8[1]=kload8q(vq0+sl_cur+512); SBAR(); MFPV(0); MFL(); MFPV(1); }
  } else {
  for(;t+5<NT;t+=2){
    STEP(pB0,pB1,pA0,pA1,t,true,true,true);     if(kdma){WAIT_BAR(2);}else{WAIT_BAR(1);} ROT();
    STEP(pA0,pA1,pB0,pB1,t+1,true,true,true);   if(kdma){WAIT_BAR(2);}else{WAIT_BAR(1);} ROT();
  }
  #define ENDW(tt) do{ if(kdma){ if((tt)+3<NT){WAIT_BAR(2);} else if((tt)+2<NT){WAIT_BAR(1);} else {WAIT_BAR(0);} } else { if((tt)+2<NT){WAIT_BAR(1);} else {WAIT_BAR(0);} } }while(0)
  for(;t+1<NT;t+=2){
    STEP(pB0,pB1,pA0,pA1,t,(t+3<NT),(t+1<NT),(t+1<NT));       ENDW(t);   ROT();
    STEP(pA0,pA1,pB0,pB1,t+1,(t+4<NT),(t+2<NT),(t+2<NT));     ENDW(t+1); ROT();
  }
  STEP(pB0,pB1,pA0,pA1,NT-1,false,false,false);
  { float sacc=pB0[0]+pB0[1]; _Pragma("unroll") for(int r=2;r<16;++r)sacc+=pB0[r]; _Pragma("unroll") for(int r=0;r<16;++r)sacc+=pB1[r]; l_reg+=sacc;
    pw0=(u32x4){PKW(pB0,0),PKW(pB0,2),PKW(pB0,4),PKW(pB0,6)};pw1=(u32x4){PKW(pB0,8),PKW(pB0,10),PKW(pB0,12),PKW(pB0,14)};pw2=(u32x4){PKW(pB1,0),PKW(pB1,2),PKW(pB1,4),PKW(pB1,6)};pw3=(u32x4){PKW(pB1,8),PKW(pB1,10),PKW(pB1,12),PKW(pB1,14)};
    SBAR(); pv(o,vb0+sl_cur,PAF(0),PAF(1),PAF(2),PAF(3)); }
  }
  #undef STEP8
  #undef GAPQ
  #undef MFL
  #undef MFPV
  #undef P8V
  #undef PK8
  #undef PKW
  #undef PAF
  #undef VFR
  #undef PIN
  #undef MX3
  #undef GAPA
  #undef GAPB
  #undef EX
  #undef VRD
  #undef KRD
  #undef STEP
  #undef MF8
  #undef ENDW
  __builtin_amdgcn_s_setprio(0);
  {auto rr=__builtin_amdgcn_permlane32_swap(__float_as_uint(l_reg),__float_as_uint(l_reg),false,false);l_reg=__uint_as_float(rr[0])+__uint_as_float(rr[1]);}
  l_reg+=__builtin_amdgcn_exp2f(sk2-mhat);
  if(hi==0)wsf[32+r32]=l_reg;asm volatile("s_waitcnt lgkmcnt(0)":::"memory");
  float rli[16];
  #pragma unroll
  for(int r=0;r<16;++r)rli[r]=__builtin_amdgcn_rcpf(Q8?lacc[r]:wsf[32+crow(r,hi)]);
  { bf16*stg=(bf16*)(shm+LDS_OST+ost*(NW*4096))+wid*2048;
    #pragma unroll
    for(int r=0;r<16;++r){const int orow=crow(r,hi);
      #pragma unroll
      for(int d0=0;d0<2;++d0)stg[orow*64+d0*32+r32]=(bf16)f2bf(o[d0][r]*rli[r]);} }
  asm volatile("s_waitcnt lgkmcnt(0)\n\ts_barrier":::"memory");
  #undef DMA_K
  #undef DMA_V
  #undef TM
  #undef CMASK
  #undef ROT
}
__device__ __forceinline__ void attn_store_plain(unsigned char*Ou,int opitch,int ost,char*shm,int wid,float osc){
  const int lane=opq(lane_id());
  const bf16*stg=(const bf16*)(shm+LDS_OST+ost*(NW*4096))+wid*2048;
  unsigned char*Ow=Ou+(long)(wid*QBLK)*opitch;
  #pragma unroll
  for(int i=0;i<4;++i){const int row=i*8+(lane>>3),ch=lane&7; const u32x4 v=*(const u32x4*)(stg+row*64+ch*8);
    int p0=__builtin_amdgcn_cvt_pk_fp8_f32(osc*bflo(v[0]),osc*bfhi(v[0]),0,false); p0=__builtin_amdgcn_cvt_pk_fp8_f32(osc*bflo(v[1]),osc*bfhi(v[1]),p0,true);
    int p1=__builtin_amdgcn_cvt_pk_fp8_f32(osc*bflo(v[2]),osc*bfhi(v[2]),0,false); p1=__builtin_amdgcn_cvt_pk_fp8_f32(osc*bflo(v[3]),osc*bfhi(v[3]),p1,true);
    *(v2u*)(Ow+(long)row*opitch+ch*8)=(v2u){(unsigned)p0,(unsigned)p1};}
  asm volatile("s_waitcnt lgkmcnt(0)":::"memory");
}
__device__ __forceinline__ void attn_store_diff(unsigned char*Ou,int opitch,float lam,float post,const float*subln,char*shm,int wid){
  const int lane=opq(lane_id());
  const bf16*s0=(const bf16*)(shm+LDS_OST)+wid*2048; const bf16*s1=(const bf16*)(shm+LDS_OST+NW*4096)+wid*2048;
  unsigned char*Ow=Ou+(long)(wid*QBLK)*opitch;
  #pragma unroll
  for(int i=0;i<4;++i){const int row=i*8+(lane>>3),ch=lane&7;
    const u32x4 a=*(const u32x4*)(s0+row*64+ch*8), b=*(const u32x4*)(s1+row*64+ch*8);
    float d[8]; float ss=0.f;
    #pragma unroll
    for(int j=0;j<4;++j){ d[2*j]=bflo(a[j])-lam*bflo(b[j]); d[2*j+1]=bfhi(a[j])-lam*bfhi(b[j]); ss+=d[2*j]*d[2*j]+d[2*j+1]*d[2*j+1]; }
    ss+=lane_xor<1>(ss); ss+=lane_xor<2>(ss); ss+=lane_xor<4>(ss);
    const float rs=__builtin_amdgcn_rsqf(ss*(1.f/64.f)+1e-6f)*post;
    #pragma unroll
    for(int j=0;j<8;++j) d[j]*=rs*subln[ch*8+j];
    int p0=__builtin_amdgcn_cvt_pk_fp8_f32(d[0],d[1],0,false); p0=__builtin_amdgcn_cvt_pk_fp8_f32(d[2],d[3],p0,true);
    int p1=__builtin_amdgcn_cvt_pk_fp8_f32(d[4],d[5],0,false); p1=__builtin_amdgcn_cvt_pk_fp8_f32(d[6],d[7],p1,true);
    *(v2u*)(Ow+(long)row*opitch+ch*8)=(v2u){(unsigned)p0,(unsigned)p1}; }
  asm volatile("s_waitcnt lgkmcnt(0)":::"memory");
}
#undef WAIT_BAR
}
constexpr int NWAVES = 8, NTHR = 512;
constexpr int DM = 1024, NB = 2, SEQ = 16384, CTX = 256, TB = SEQ + CTX, MROWS = NB * TB, NPAN = MROWS / 256, PANB = TB / 256;
constexpr int MIXC = 2816, GATEC = 4096, NLAYER = 2, PQC = 2048, NEXP = 16384;
constexpr float ALPHA = 1.4142135623730951f, LOG2E = 1.4426950408889634f;
constexpr float C2A = 0.125f * LOG2E, C2B = 0.17677669529663687f * LOG2E;
constexpr int CA_Q = 0, CA_K = 256, CA_V = 384, CB_Q = 512, CB_K = 768, CB_V = 1024, CC_Q = 1280, CC_K = 1536, CC_V = 1664, CD_Q = 1792, CD_K = 2048, CD_V = 2304, CD_G = 2560;
constexpr size_t MiB = 1u << 20;
constexpr size_t WS_CTL = 0, CTL_ZERO_BYTES = 64 * 1024;
constexpr size_t WS_MOD = 1 * MiB;
constexpr size_t WS_SC = WS_MOD + 256 * 1024;
constexpr size_t WS_AX64 = WS_MOD + 320 * 1024;
constexpr size_t WS_AX32 = WS_MOD + 384 * 1024;
constexpr size_t WS_ROPE = 2 * MiB;
constexpr size_t WS_HC = 7 * MiB;
constexpr size_t WS_WIN = 10 * MiB;
constexpr size_t WS_WB = 24 * MiB;
constexpr size_t WS_WO = 26 * MiB;
constexpr size_t WS_WQ = 28 * MiB;
constexpr size_t WS_SK = 32 * MiB;
constexpr size_t WS_PU = 33 * MiB;
constexpr size_t WS_PV = 49 * MiB;
constexpr size_t WS_SU = 65 * MiB, WS_SV = 65 * MiB + 65536;
constexpr size_t WS_WQ8 = 66 * MiB, WS_SWQ = 68 * MiB;
constexpr size_t WS_QK8 = 70 * MiB;
constexpr size_t WS_V8T = 84 * MiB;
constexpr size_t WS_QK8B = 196 * MiB, WS_V8TB = 213 * MiB;
constexpr size_t WS_U = 97 * MiB;
constexpr size_t WS_OCAT = 162 * MiB;
constexpr float OSC_AC = 32.f, OSC_B = 16.f, OSC_D = 16.f;
constexpr size_t WS_BIG = 227 * MiB;
constexpr size_t WS_KV = WS_BIG + 179 * MiB;
constexpr size_t WS_PS = WS_KV + 17 * MiB;
constexpr size_t WS_SEL = WS_BIG + 130 * MiB;
constexpr size_t WS_DOT = WS_BIG + 163 * MiB;
constexpr size_t WS_XQ = WS_BIG + 180 * MiB;
constexpr size_t WS_SX = WS_BIG + 213 * MiB;
constexpr size_t WS_ST = WS_BIG + 214 * MiB;
constexpr size_t WS_U8 = WS_BIG + 216 * MiB;
constexpr size_t WS_END = 487 * MiB;
static_assert((size_t)MROWS * MIXC * 2 <= 179 * MiB && WS_PS + 9 * MiB <= WS_END && WS_SEL + (size_t)MROWS * 128 * 8 <= WS_END && WS_BIG + (size_t)MROWS * GATEC * 2 <= WS_END, "ws map");
constexpr int CW_BAR = 1024;
constexpr int CW_RANK = 6144;
constexpr int CW_KM = 8192;
constexpr int SCRATCH_BYTES = 139264, MISC_OFF = SCRATCH_BYTES, LDS_BYTES = 147456;
static_assert(attn_body::LDS_BYTES <= SCRATCH_BYTES && pg8::STAGE_BYTES <= SCRATCH_BYTES, "lds");

struct Params { const float* in[21]; float* out; unsigned char* ws; };
enum { I_X = 0, I_C, I_CTX, I_CCTX, I_WMOD, I_BMOD, I_WIN, I_QKG, I_DLAM, I_DSUB, I_SINK, I_RDEC, I_RNORM, I_WBR, I_WOUT, I_LNA, I_LNF, I_PWQ, I_PSK, I_PU, I_PV };

static __device__ const double kInv32[32] = {1, 0.74989420933245587, 0.56234132519034907, 0.42169650342858223, 0.31622776601683794, 0.23713737056616552, 0.17782794100389229, 0.1333521432163324, 0.10000000000000001, 0.074989420933245579, 0.056234132519034911, 0.042169650342858224, 0.031622776601683791, 0.023713737056616554, 0.017782794100389229, 0.013335214321633241, 0.01, 0.0074989420933245579, 0.005623413251903491, 0.0042169650342858229, 0.0031622776601683794, 0.0023713737056616554, 0.0017782794100389228, 0.0013335214321633241, 0.001, 0.00074989420933245586, 0.0005623413251903491, 0.00042169650342858224, 0.00031622776601683794, 0.00023713737056616554, 0.00017782794100389227, 0.0001333521432163324};

struct Ctx {
    LAS unsigned char* lds; unsigned char* ws; int tid, lane, wave, G, vcu, gw, NGW, bx;
};
__device__ __forceinline__ float* hrow(const Params& P, int r) {
    const int b = r >= TB ? 1 : 0, t = r - b * TB;
    return t < CTX ? (float*)(P.ws + WS_HC) + (size_t)(b * CTX + t) * DM : P.out + (size_t)(b * SEQ + t - CTX) * DM;
}
__device__ __forceinline__ float silu_(float x) { return x * sigmoidf_(x); }
__device__ __forceinline__ float lg2_of(float decay) { return -log1pf(__expf(-decay)) * LOG2E; }

__device__ __forceinline__ void p0_transpose_item(const float* W, int K, int N, bf16* WT, LAS float* scr, int item, int lane, int remap_below = 0, int fp8_from = 1 << 30) {
    const int nblk = N / 32, kb = item / nblk, nb = item % nblk, k0 = 64 * kb, n0 = 32 * nb;
    const int nd0 = n0 < remap_below ? ((n0 & ~255) | (((n0 >> 5) & 1) << 7) | (((n0 >> 6) & 3) << 5)) : n0;
#pragma unroll 8
    for (int i = 0; i < 32; ++i) { const int kk = 2 * i + (lane >> 5); scr[kk * 33 + (lane & 31)] = W[(size_t)(k0 + kk) * N + n0 + (lane & 31)]; }
    LDS_WAIT(); asm volatile("" ::: "memory");
    const int c = lane & 7;
#pragma unroll
    for (int j = 0; j < 4; ++j) { const int n = (lane >> 3) + 8 * j; const LAS float* s = scr + (8 * c) * 33 + n;
        v4u o; o.x = pk2(s[0 * 33], s[1 * 33]); o.y = pk2(s[2 * 33], s[3 * 33]); o.z = pk2(s[4 * 33], s[5 * 33]); o.w = pk2(s[6 * 33], s[7 * 33]);
        if (nd0 >= fp8_from) {
            int w0 = __builtin_amdgcn_cvt_pk_fp8_f32(32.f * s[0 * 33], 32.f * s[1 * 33], 0, false); w0 = __builtin_amdgcn_cvt_pk_fp8_f32(32.f * s[2 * 33], 32.f * s[3 * 33], w0, true);
            int w1 = __builtin_amdgcn_cvt_pk_fp8_f32(32.f * s[4 * 33], 32.f * s[5 * 33], 0, false); w1 = __builtin_amdgcn_cvt_pk_fp8_f32(32.f * s[6 * 33], 32.f * s[7 * 33], w1, true);
            *(v2u*)((unsigned char*)(WT + (size_t)fp8_from * K) + (size_t)(nd0 - fp8_from + n) * K + k0 + 8 * c) = (v2u){(unsigned)w0, (unsigned)w1}; }
        else *(v4u*)(WT + (size_t)(nd0 + n) * K + k0 + 8 * c) = o; }
    LDS_WAIT(); asm volatile("" ::: "memory");
}
__device__ __forceinline__ void cvt_stream(const float* src, bf16* dst, size_t n, int gt, int NGT) {
    for (size_t i = (size_t)gt * 8; i < n; i += (size_t)NGT * 8) {
        const f32x4 a = *(const f32x4*)(src + i), b = *(const f32x4*)(src + i + 4);
        v4u o; o.x = pk2(a.x, a.y); o.y = pk2(a.z, a.w); o.z = pk2(b.x, b.y); o.w = pk2(b.z, b.w);
        *(v4u*)(dst + i) = o; }
}
__device__ __forceinline__ void ph_convert(const Params& P, const Ctx& F, int l) {
    LAS float* scr = (LAS float*)(F.lds + F.wave * 16384);
    constexpr int I_IN = 16 * 216, I_BR = 4 * 32, I_O = 16 * 32, I_Q = 16 * 64, NIT = I_IN + 4 * I_BR + I_O + I_Q;
    for (int it = F.gw; it < NIT; it += F.NGW) {
        int r = it;
        if (r < I_IN) { p0_transpose_item(P.in[I_WIN] + (size_t)l * DM * 6912, DM, 6912, (bf16*)(F.ws + WS_WIN), scr, r, F.lane, MIXC, 0); continue; } r -= I_IN;
        if (r < 4 * I_BR) { const int i = r / I_BR; p0_transpose_item(P.in[I_WBR] + (size_t)(l * 4 + i) * 256 * DM, 256, DM, (bf16*)(F.ws + WS_WB + (size_t)i * DM * 256), scr, r % I_BR, F.lane, 0, 0); continue; }   r -= 4 * I_BR;
        if (r < I_O) { p0_transpose_item(P.in[I_WOUT] + (size_t)l * DM * DM, DM, DM, (bf16*)(F.ws + WS_WO), scr, r, F.lane, 0, 0); continue; } r -= I_O;
        p0_transpose_item(P.in[I_PWQ] + (size_t)l * DM * PQC, DM, PQC, (bf16*)(F.ws + WS_WQ), scr, r, F.lane);
    }
    if (F.gw == 0) {
        const float g1 = P.in[I_QKG][l * 128 + 64 + F.lane]; const float ga = wave_max(g1 * g1) * 64.f * 1.02f;
        if (F.lane == 0) { unsigned* KM = (unsigned*)(F.ws + WS_CTL) + CW_KM + l * 12; atomicMax(KM + 0, __builtin_bit_cast(unsigned, ga)); atomicMax(KM + 1, __builtin_bit_cast(unsigned, ga)); } }
    const int gt = F.gw * 64 + F.lane, NGT = F.NGW * 64;
    cvt_stream(P.in[I_PSK] + (size_t)l * 262144, (bf16*)(F.ws + WS_SK), 262144, gt, NGT);
#define PCV_SRC(e_) (P.in[(e_) >= NEXP ? I_PV : I_PU] + ((size_t)l * NEXP + ((e_) >= NEXP ? (e_) - NEXP : (e_))) * DM + 16 * F.lane)
    f32x4 vn[4];
    { const int e0 = F.gw < 2 * NEXP ? F.gw : 0; const float* s0 = PCV_SRC(e0);
#pragma unroll
      for (int j = 0; j < 4; ++j) vn[j] = *(const f32x4*)(s0 + 4 * j); }
    for (int e = F.gw; e < 2 * NEXP; e += F.NGW) {
        const bool isv = e >= NEXP; const int ee = isv ? e - NEXP : e;
        f32x4 v[4]; float mx = 0.f;
        { const int en = e + F.NGW < 2 * NEXP ? e + F.NGW : e; const float* sn = PCV_SRC(en);
#pragma unroll
          for (int j = 0; j < 4; ++j) { v[j] = vn[j]; vn[j] = *(const f32x4*)(sn + 4 * j); } }
#pragma unroll
        for (int j = 0; j < 4; ++j) { mx = fmaxf(mx, fmaxf(fmaxf(fabsf(v[j].x), fabsf(v[j].y)), fmaxf(fabsf(v[j].z), fabsf(v[j].w)))); }
        mx = wave_max(mx);
        const float sc = fmaxf(mx, 1e-30f) * (1.f / 127.f), inv = 1.f / sc;
        if (isv) {
            const float s4 = fmaxf(mx, 1e-30f) * (1.f / 6.f), i4 = 1.f / s4; unsigned d0 = 0u, d1 = 0u;
            d0 = __builtin_amdgcn_cvt_scalef32_pk_fp4_f32(d0, v[0].x * i4, v[0].y * i4, 1.0f, 0); d0 = __builtin_amdgcn_cvt_scalef32_pk_fp4_f32(d0, v[0].z * i4, v[0].w * i4, 1.0f, 1);
            d0 = __builtin_amdgcn_cvt_scalef32_pk_fp4_f32(d0, v[1].x * i4, v[1].y * i4, 1.0f, 2); d0 = __builtin_amdgcn_cvt_scalef32_pk_fp4_f32(d0, v[1].z * i4, v[1].w * i4, 1.0f, 3);
            d1 = __builtin_amdgcn_cvt_scalef32_pk_fp4_f32(d1, v[2].x * i4, v[2].y * i4, 1.0f, 0); d1 = __builtin_amdgcn_cvt_scalef32_pk_fp4_f32(d1, v[2].z * i4, v[2].w * i4, 1.0f, 1);
            d1 = __builtin_amdgcn_cvt_scalef32_pk_fp4_f32(d1, v[3].x * i4, v[3].y * i4, 1.0f, 2); d1 = __builtin_amdgcn_cvt_scalef32_pk_fp4_f32(d1, v[3].z * i4, v[3].w * i4, 1.0f, 3);
            *(v2u*)(F.ws + WS_PV + (size_t)ee * (DM / 2) + 8 * F.lane) = (v2u){d0, d1};
            if (F.lane == 0) ((float*)(F.ws + WS_SV))[ee] = s4;
        } else {
        v4u o;
#pragma unroll
        for (int j = 0; j < 4; ++j) { unsigned w = 0;
#pragma unroll
            for (int k = 0; k < 4; ++k) { int q = (int)rintf(v[j][k] * inv); q = q > 127 ? 127 : (q < -127 ? -127 : q); w |= (unsigned)(q & 0xff) << (8 * k); }
            o[j] = w; }
        *(v4u*)(F.ws + WS_PU + (size_t)ee * DM + 16 * F.lane) = o;
        if (F.lane == 0) ((float*)(F.ws + WS_SU))[ee] = sc; }
    }
#undef PCV_SRC
}
__device__ __forceinline__ void sincos_rev(double a, float& s, float& c) {
    double rv = a * 0.15915494309189535; rv -= floor(rv); const float f = (float)rv;
    s = __builtin_amdgcn_sinf(f); c = __builtin_amdgcn_cosf(f);
}
__device__ __forceinline__ void ph_tables(const Params& P, const Ctx& F) {
    LAS float* cond = (LAS float*)F.lds;
    LAS float* part = (LAS float*)(F.lds + 16384);
    for (int i = F.tid; i < 3 * DM; i += NTHR) { const int v = i >> 10, k = i & 1023; const float x = v < 2 ? P.in[I_C][v * DM + k] : P.in[I_CCTX][k]; cond[i] = silu_(x); }
    __syncthreads();
    float* MOD = (float*)(F.ws + WS_MOD);
    for (int u = F.bx; u < 2 * 96; u += F.G) {
        const int l = u / 96, n0 = (u % 96) * 64;
        const float* W = P.in[I_WMOD] + (size_t)l * DM * 6144 + n0 + F.lane;
        float a0 = 0.f, a1 = 0.f, a2 = 0.f;
        const int k0 = F.wave * 128;
#pragma unroll 8
        for (int k = 0; k < 128; ++k) { const float w = W[(size_t)(k0 + k) * 6144]; a0 += cond[k0 + k] * w; a1 += cond[DM + k0 + k] * w; a2 += cond[2 * DM + k0 + k] * w; }
        part[(F.wave * 3 + 0) * 64 + F.lane] = a0; part[(F.wave * 3 + 1) * 64 + F.lane] = a1; part[(F.wave * 3 + 2) * 64 + F.lane] = a2;
        __syncthreads();
        if (F.tid < 192) { const int v = F.tid >> 6, n = F.tid & 63; float s = 0.f;
#pragma unroll
            for (int w = 0; w < 8; ++w) s += part[(w * 3 + v) * 64 + n];
            MOD[(size_t)(l * 3 + v) * 6144 + n0 + n] = s + P.in[I_BMOD][l * 6144 + n0 + n]; }
        __syncthreads();
    }
    if (F.bx == F.G - 1 && F.wave == 0) {
        float* SC = (float*)(F.ws + WS_SC);
        for (int l = 0; l < NLAYER; ++l) { const float* p = P.in[I_DLAM] + l * 128;
            const float a = F.lane < 32 ? p[F.lane] * p[32 + F.lane] : 0.f, b = F.lane < 32 ? p[64 + F.lane] * p[96 + F.lane] : 0.f;
            const float sa = wave_sum(a), sb = wave_sum(b); const float li = 0.8f - 0.6f * __expf(-0.3f * (float)l);
            if (F.lane == 0) { SC[l * 4 + 0] = __expf(sa) - __expf(sb) + li; SC[l * 4 + 1] = 1.f - li; } }
        if (F.lane < 16) SC[16 + F.lane] = lg2_of(P.in[I_RDEC][F.lane]);
    }
    const int gt = F.gw * 64 + F.lane, NGT = F.NGW * 64;
    f32x2* ROPE = (f32x2*)(F.ws + WS_ROPE); f32x2* AX64 = (f32x2*)(F.ws + WS_AX64); f32x2* AX32 = (f32x2*)(F.ws + WS_AX32);
    for (int i = gt; i < TB * 32 + 256 * 16 + 256 * 8; i += NGT) {
        float s, c;
        if (i < TB * 32) { sincos_rev((double)(i >> 5) * kInv32[i & 31], s, c); ROPE[i] = (f32x2){c, s}; }
        else if (i < TB * 32 + 4096) { const int j = i - TB * 32; sincos_rev((double)(j >> 4) * kInv32[2 * (j & 15)], s, c); AX64[j] = (f32x2){c, s}; }
        else { const int j = i - TB * 32 - 4096; sincos_rev((double)(j >> 3) * kInv32[4 * (j & 7)], s, c); AX32[j] = (f32x2){c, s}; }
    }
}
__device__ __forceinline__ void ph_mod0(const Params& P, const Ctx& F) {
    const float* MOD = (const float*)(F.ws + WS_MOD);
    bf16* U = (bf16*)(F.ws + WS_U);
    for (int r = F.gw; r < MROWS; r += F.NGW) {
        const int b = r >= TB ? 1 : 0, t = r - b * TB;
        const float* src = t < CTX ? P.in[I_CTX] + (size_t)(b * CTX + t) * DM : P.in[I_X] + (size_t)(b * SEQ + t - CTX) * DM;
        float* hd = hrow(P, r);
        const float* m = MOD + (size_t)(t < CTX ? 2 : b) * 6144;
#pragma unroll
        for (int j = 0; j < 4; ++j) { const int c = 4 * F.lane + 256 * j;
            const f32x4 v = *(const f32x4*)(src + c), sh = *(const f32x4*)(m + c), sc = *(const f32x4*)(m + DM + c);
            *(f32x4*)(hd + c) = v;
            const f32x4 u = v * (sc + 1.f) + sh;
            int w8 = __builtin_amdgcn_cvt_pk_fp8_f32(u.x, u.y, 0, false); w8 = __builtin_amdgcn_cvt_pk_fp8_f32(u.z, u.w, w8, true);
            *(unsigned*)(F.ws + WS_U8 + (size_t)r * DM + c) = (unsigned)w8; }
    }
}
__device__ __forceinline__ void ph_ret_kv(const Params& P, const Ctx& F, int l) {
    using namespace attn_body;
    const bf16* PROJ = (const bf16*)(F.ws + WS_BIG); float* KV = (float*)(F.ws + WS_KV);
    char* shm = (char*)F.lds; const unsigned lds0 = (unsigned)(uintptr_t)shm;
    LAS float* wt = (LAS float*)(F.lds + 65536);
    const int lane = F.lane, wid = F.wave, r32 = lane & 31, hi = lane >> 5;
    const int dir = wid >> 2, dkb = (wid >> 1) & 1, dvb = wid & 1;
    const lds_cptr shm3 = (lds_cptr)shm;
    const lds_cptr trb = shm3 + ((lane >> 4) & 1) * 32 + (lane & 3) * 8 + (4 * hi + ((lane & 15) >> 2)) * 64;
    for (int u = F.vcu; u < NB * 4 * PANB; u += F.G) {
        const int c = u % PANB, bh = u / PANB, h = bh & 3, b = bh >> 2; const size_t r0 = (size_t)b * TB + c * 256;
        const float* LG = (const float*)(F.ws + WS_SC) + 16 + l * 8; const float lgf = LG[h], lgb = LG[4 + h];
        const bf16* ksrc = PROJ + (r0 + 16 * (wid & 3) + (lane >> 2)) * MIXC + CD_K + h * 64 + (wid >> 2) * 32 + (lane & 3) * 8;
        const bf16* vsrc = ksrc + (CD_V - CD_K);
#pragma unroll
        for (int t = 0; t < 4; ++t) { glds16(ksrc + (size_t)t * 64 * MIXC, (unsigned)__builtin_amdgcn_readfirstlane(lds0 + t * 8192 + wid * 1024));
                                      glds16(vsrc + (size_t)t * 64 * MIXC, (unsigned)__builtin_amdgcn_readfirstlane(lds0 + 32768 + t * 8192 + wid * 1024)); }
        { const int j = F.tid & 255; wt[F.tid] = F.tid < 256 ? ex2((float)(255 - j) * lgf) : ex2((float)j * lgb); }
        asm volatile("s_waitcnt vmcnt(0) lgkmcnt(0)\n\ts_barrier" ::: "memory");
        f32x16 acc = zero16();
#pragma unroll 4
        for (int ks = 0; ks < 16; ++ks) {
            const int so = (ks >> 2) * 8192 + (ks & 3) * 1024;
            const s16x4 klo = vtr(trb + so + dkb * 4096), khi = vtr(trb + so + dkb * 4096 + 512);
            const s16x4 vlo = vtr(trb + 32768 + so + dvb * 4096), vhi = vtr(trb + 32768 + so + dvb * 4096 + 512);
            const f32x4 w0 = *(const LAS f32x4*)(wt + dir * 256 + 16 * ks + 4 * hi), w1 = *(const LAS f32x4*)(wt + dir * 256 + 16 * ks + 8 + 4 * hi);
            u32x4 aw;
            aw.x = cvtpk_s(bf1((bf16)klo[0]) * w0.x, bf1((bf16)klo[1]) * w0.y); aw.y = cvtpk_s(bf1((bf16)klo[2]) * w0.z, bf1((bf16)klo[3]) * w0.w);
            aw.z = cvtpk_s(bf1((bf16)khi[0]) * w1.x, bf1((bf16)khi[1]) * w1.y); aw.w = cvtpk_s(bf1((bf16)khi[2]) * w1.z, bf1((bf16)khi[3]) * w1.w);
            const bf16x8 bv = (bf16x8){vlo[0], vlo[1], vlo[2], vlo[3], vhi[0], vhi[1], vhi[2], vhi[3]};
            acc = __builtin_amdgcn_mfma_f32_32x32x16_bf16(bv, __builtin_bit_cast(bf16x8, aw), acc, 0, 0, 0);
        }
        float* o = KV + ((((size_t)bh * 2 + dir) * PANB + c) * 64 + 32 * dvb) * 64 + 32 * dkb + r32;
#pragma unroll
        for (int i = 0; i < 16; ++i) o[(size_t)crow(i, hi) * 64] = acc[i];
        asm volatile("s_waitcnt lgkmcnt(0)\n\ts_barrier" ::: "memory");
    }
}
__device__ __forceinline__ void ph_ret_scan(const Params& P, const Ctx& F, int l) {
    const float* KV = (const float*)(F.ws + WS_KV); bf16* PS = (bf16*)(F.ws + WS_PS);
    for (int e = F.bx * NTHR + F.tid; e < 16 * 4096; e += F.G * NTHR) {
        const int seq = e >> 12, el = e & 4095, dv = el >> 6, dk = el & 63, dir = seq & 1, h = (seq >> 1) & 3;
        const float gC = ex2(256.f * ((const float*)(F.ws + WS_SC))[16 + l * 8 + dir * 4 + h]);
        const float* kv = KV + (size_t)seq * PANB * 4096 + dv * 64 + dk; bf16* ps = PS + (size_t)seq * PANB * 4096 + dv * 64 + dk;
        float S = 0.f;
        if (dir == 0) { for (int c = 0; c < PANB; ++c) { ps[(size_t)c * 4096] = (bf16)f2bf(S); S = S * gC + kv[(size_t)c * 4096]; } }
        else { ps[0] = 0; S = kv[0]; for (int c = PANB - 1; c >= 1; --c) { ps[(size_t)c * 4096] = (bf16)f2bf(S); S = S * gC + kv[(size_t)c * 4096]; } }
    }
}
__device__ __forceinline__ void ret_unit(const Params& P, const Ctx& F, int l, int b, int h, int c) {
    using namespace attn_body;
    const bf16* PROJ = (const bf16*)(F.ws + WS_BIG); const bf16* PS = (const bf16*)(F.ws + WS_PS); unsigned char* OCAT = F.ws + WS_OCAT;
    char* shm = (char*)F.lds;
    const int lane = F.lane, r32 = lane & 31, hi = lane >> 5, wid = F.wave;
    const size_t r0 = (size_t)b * TB + c * 256;
    const float* LG = (const float*)(F.ws + WS_SC) + 16 + l * 8; const float lgf = LG[h], lgb = LG[4 + h];
    const unsigned lds0 = (unsigned)(uintptr_t)shm;
    const bf16* ksrc = PROJ + (r0 + lane) * MIXC + CD_K + h * 64 + wid * 8;
    const bf16* vsrc = PROJ + (r0 + 16 * (wid & 3) + (lane >> 2)) * MIXC + CD_V + h * 64 + (wid >> 2) * 32 + (lane & 3) * 8;
#pragma unroll
    for (int t = 0; t < 4; ++t) { glds16(ksrc + (size_t)t * 64 * MIXC, (unsigned)__builtin_amdgcn_readfirstlane(lds0 + t * 8192 + wid * 1024));
                                  glds16(vsrc + (size_t)t * 64 * MIXC, (unsigned)__builtin_amdgcn_readfirstlane(lds0 + 32768 + t * 8192 + wid * 1024)); }
    bf16x8 qr[4];
    const bf16* Qw = PROJ + (r0 + wid * 32 + r32) * MIXC + CD_Q + h * 64;
#pragma unroll
    for (int d0 = 0; d0 < 4; ++d0) qr[d0] = *reinterpret_cast<const bf16x8*>(Qw + d0 * 16 + hi * 8);
    asm volatile("s_waitcnt vmcnt(0) lgkmcnt(0)\n\ts_barrier" ::: "memory");
    f32x16 o[2]; o[0] = zero16(); o[1] = zero16();
    const lds_cptr shm3 = (lds_cptr)shm;
    const int vb0 = (int)(lds0 + 32768) + ((lane >> 4) & 1) * 32 + (lane & 3) * 8 + (4 * hi + ((lane & 15) >> 2)) * 64;
    const int qi = wid * 32 + r32;
    for (int t = 0; t < 4; ++t) {
        f32x16 p0, p1;
        { const f32x16 zero = zero16(); qkt(p0, p1, shm3 + t * 8192, qr, zero, r32, hi); }
#pragma unroll
        for (int r = 0; r < 16; ++r) {
            const int d0 = qi - (64 * t + crow(r, hi)), d1 = d0 - 32;
            const float w0 = d0 == 0 ? 2.f : ex2(d0 > 0 ? (float)d0 * lgf : (float)(-d0) * lgb);
            const float w1 = d1 == 0 ? 2.f : ex2(d1 > 0 ? (float)d1 * lgf : (float)(-d1) * lgb);
            p0[r] *= w0; p1[r] *= w1; }
        u32x4 pw0, pw1, pw2, pw3;
        pw0 = (u32x4){cvtpk_s(p0[0], p0[1]), cvtpk_s(p0[2], p0[3]), cvtpk_s(p0[4], p0[5]), cvtpk_s(p0[6], p0[7])};
        pw1 = (u32x4){cvtpk_s(p0[8], p0[9]), cvtpk_s(p0[10], p0[11]), cvtpk_s(p0[12], p0[13]), cvtpk_s(p0[14], p0[15])};
        pw2 = (u32x4){cvtpk_s(p1[0], p1[1]), cvtpk_s(p1[2], p1[3]), cvtpk_s(p1[4], p1[5]), cvtpk_s(p1[6], p1[7])};
        pw3 = (u32x4){cvtpk_s(p1[8], p1[9]), cvtpk_s(p1[10], p1[11]), cvtpk_s(p1[12], p1[13]), cvtpk_s(p1[14], p1[15])};
        SBAR();
        pv(o, vb0 + t * 8192, __builtin_bit_cast(bf16x8, pw0), __builtin_bit_cast(bf16x8, pw1), __builtin_bit_cast(bf16x8, pw2), __builtin_bit_cast(bf16x8, pw3));
    }
#pragma unroll
    for (int dir = 0; dir < 2; ++dir) {
        const bf16* ps = PS + ((((size_t)(b * 4 + h)) * 2 + dir) * PANB + c) * 4096;
        f32x16 T[2]; T[0] = zero16(); T[1] = zero16();
#pragma unroll
        for (int d = 0; d < 2; ++d)
#pragma unroll
            for (int s = 0; s < 4; ++s) { const bf16x8 bb = *reinterpret_cast<const bf16x8*>(ps + (32 * d + r32) * 64 + 16 * s + 8 * hi);
                T[d] = __builtin_amdgcn_mfma_f32_32x32x16_bf16(qr[s], bb, T[d], 0, 0, 0); }
#pragma unroll
        for (int r = 0; r < 16; ++r) { const int q = wid * 32 + crow(r, hi);
            const float xi = dir == 0 ? ex2((float)(q + 1) * lgf) : ex2((float)(256 - q) * lgb);
            o[0][r] += xi * T[0][r]; o[1][r] += xi * T[1][r]; }
    }
    float* stg = (float*)(shm + 65536) + wid * 2048;
#pragma unroll
    for (int r = 0; r < 16; ++r) { const int orow = crow(r, hi); stg[orow * 64 + r32] = o[0][r]; stg[orow * 64 + 32 + r32] = o[1][r]; }
    asm volatile("s_waitcnt lgkmcnt(0)" ::: "memory");
    const float* rn0 = P.in[I_RNORM] + l * 512 + h * 64; const float* rn1 = rn0 + 256;
#pragma unroll
    for (int i = 0; i < 4; ++i) { const int row = i * 8 + (lane >> 3), ch = lane & 7;
        const f32x4 a = *(const f32x4*)(stg + row * 64 + ch * 8), bq = *(const f32x4*)(stg + row * 64 + ch * 8 + 4);
        float v[8] = {a.x, a.y, a.z, a.w, bq.x, bq.y, bq.z, bq.w};
        float s = 0.f;
#pragma unroll
        for (int j = 0; j < 8; ++j) s += v[j];
        s += lane_xor<1>(s); s += lane_xor<2>(s); s += lane_xor<4>(s);
        const float mu = s * (1.f / 64.f); float q2 = 0.f;
#pragma unroll
        for (int j = 0; j < 8; ++j) { v[j] -= mu; q2 += v[j] * v[j]; }
        q2 += lane_xor<1>(q2); q2 += lane_xor<2>(q2); q2 += lane_xor<4>(q2);
        const float rs = __builtin_amdgcn_rsqf(q2 * (1.f / 64.f) + 1e-5f);
        const size_t rr = r0 + wid * 32 + row;
        const v4u gg = *(const v4u*)(PROJ + rr * MIXC + CD_G + h * 64 + ch * 8);
        float outv[8];
#pragma unroll
        for (int j = 0; j < 8; ++j) { const float g = (j & 1) ? bfhi(gg[j >> 1]) : bflo(gg[j >> 1]);
            outv[j] = (v[j] * rs * rn0[ch * 8 + j] + rn1[ch * 8 + j]) * silu_(g); }
        int p0 = __builtin_amdgcn_cvt_pk_fp8_f32(OSC_D * outv[0], OSC_D * outv[1], 0, false); p0 = __builtin_amdgcn_cvt_pk_fp8_f32(OSC_D * outv[2], OSC_D * outv[3], p0, true);
        int p1 = __builtin_amdgcn_cvt_pk_fp8_f32(OSC_D * outv[4], OSC_D * outv[5], 0, false); p1 = __builtin_amdgcn_cvt_pk_fp8_f32(OSC_D * outv[6], OSC_D * outv[7], p1, true);
        *(v2u*)(OCAT + rr * DM + 768 + h * 64 + ch * 8) = (v2u){(unsigned)p0, (unsigned)p1}; }
    asm volatile("s_waitcnt lgkmcnt(0)\n\ts_barrier" ::: "memory");
}

__device__ __forceinline__ void ph_mix(const Params& P, const Ctx& F, int l, bool need_ctx) {
    using namespace attn_body;
    const bf16* PROJ = (const bf16*)(F.ws + WS_BIG); unsigned char* OCAT = F.ws + WS_OCAT;
    const float* SC = (const float*)(F.ws + WS_SC);
    const float lam = SC[l * 4 + 0], post = SC[l * 4 + 1];
    char* shm = (char*)F.lds;
    const int nF = (512 - F.vcu + F.G - 1) / F.G;
    const int NS = 512 + (need_ctx ? 24 : 0);
    const int nS = F.vcu < NS ? (NS - F.vcu + F.G - 1) / F.G : 0;
    for (int ui = 0; ui < 2 * nF + nS; ++ui) {
        int type, b, hd, qb;
        if (ui < 2 * nF) { const int f = F.vcu + (ui % nF) * F.G; type = ui < nF ? 1 : 0; b = f >> 8; hd = (f >> 6) & 3; qb = (f & 63) + 1; }
        else { const int s = F.vcu + (ui - 2 * nF) * F.G;
            if (s < 512) { type = 2; b = s >> 8; hd = (s >> 6) & 3; qb = (s & 63) + 1; }
            else { const int s2 = s - 512; type = s2 < 8 ? 2 : (s2 < 16 ? 0 : 1); b = (s2 & 7) >> 2; hd = s2 & 3; qb = 0; } }
        const size_t r0 = (size_t)b * TB + qb * 256;
        const bf16* base = PROJ + (size_t)b * TB * MIXC;
        const int kvh = hd >> 1;
        const bf16* Qp = PROJ + r0 * MIXC + (type == 0 ? CA_Q : type == 1 ? CB_Q : CC_Q) + hd * 64;
        const bf16* Kp = base + (type == 0 ? CA_K + kvh * 64 : type == 1 ? CB_K + hd * 64 : CC_K + kvh * 64);
        const bf16* Vp = base + (type == 0 ? CA_V + kvh * 64 : type == 1 ? CB_V + hd * 64 : CC_V + kvh * 64);
        int NT = qb ? 260 : 4, woff = 0, q0lat = 0, win = 0; float sk2 = -INFINITY;
        const unsigned* KM = (const unsigned*)(F.ws + WS_CTL) + CW_KM + l * 12;
        const int kmi = type == 0 ? kvh : type == 1 ? 2 + 2 * hd : 10 + kvh;
        if (type == 2) { sk2 = P.in[I_SINK][l * 4 + hd] * LOG2E;
            if (qb) { q0lat = (qb - 1) * 256; const int wlo = (q0lat >= 128 ? q0lat - 128 : 0) >> 6, whi = (q0lat + 384 <= SEQ ? q0lat + 384 : SEQ) >> 6; NT = 4 + whi - wlo; woff = wlo; win = 1; } }
        unsigned char* Op = OCAT + r0 * DM + (type == 0 ? 0 : type == 1 ? 256 : 512) + hd * 64;
        if (type == 2) {
            if (win) attn_core<8, false, true>(Qp, MIXC, Kp, Vp, MIXC, NT, woff, q0lat, win, __builtin_sqrtf(__builtin_bit_cast(float, KM[kmi])), sk2, 0, shm, F.wave);
            else attn_core<8, false, false>(Qp, MIXC, Kp, Vp, MIXC, NT, woff, q0lat, win, __builtin_sqrtf(__builtin_bit_cast(float, KM[kmi])), sk2, 0, shm, F.wave);
        } else {
            const unsigned char* Q8r = type == 1 ? F.ws + WS_QK8B : F.ws + WS_QK8; const int q8p = type == 1 ? 512 : QK8P;
            const unsigned char* Q8u = Q8r + r0 * q8p + hd * 64;
            const unsigned char* K8h = Q8r + (size_t)b * TB * q8p + 256 + (type == 1 ? hd : kvh) * 64;
            const unsigned char* V8h = type == 1 ? F.ws + WS_V8TB + (size_t)((b * 4 + hd) * 64) * VTP : F.ws + WS_V8T + (size_t)((b * 2 + kvh) * 64) * VTP;
            for (int ps = 0; ps < (type == 1 ? 2 : 1); ++ps)
                attn_core<8, false, false, true>(Qp, MIXC, Kp, Vp, MIXC, NT, woff, q0lat, win, __builtin_sqrtf(__builtin_bit_cast(float, KM[kmi + ps])), sk2, ps, shm, F.wave,
                                                 Q8u, K8h, V8h, q8p, type == 1 ? ps : -1);
        }
        if (type == 1) attn_store_diff(Op, DM, lam, post * OSC_B, P.in[I_DSUB] + l * 64, shm, F.wave);
        else attn_store_plain(Op, DM, 0, shm, F.wave, OSC_AC);
    }
    __syncthreads();
    for (int u = F.vcu; u < NB * 4 * PANB; u += F.G) {
        const int c = u % PANB, bh = u / PANB;
        if (c == 0 && !need_ctx) continue;
        ret_unit(P, F, l, bh >> 2, bh & 3, c);
    }
}
template <int ACT> struct EpiStore {
    static constexpr bool PERM = true;
    bf16* O; int ldc; float pre;
    __device__ __forceinline__ void operator()(const pg8::f32x4 (&acc)[2][2][4][2], const pg8::Unit& u, int wr, int wc, int fr_, int fq_) const {
        const int ln_ = opq(lane_id()), fr = ln_ & 15, fq = ln_ >> 4;
        const int row0 = u.pm * 256 + wr * 64 + fr, col0 = u.pn * 256 + wc * 32 + 8 * fq;
#pragma unroll
        for (int ai = 0; ai < 2; ++ai)
#pragma unroll
            for (int m = 0; m < 4; ++m) { bf16* rowp = O + (size_t)(row0 + ai * 128 + m * 16) * ldc + col0;
#pragma unroll
                for (int bj = 0; bj < 2; ++bj) { pg8::f32x4 v0 = acc[ai][bj][m][0], v1 = acc[ai][bj][m][1];
                    if (ACT == 1) {
#pragma unroll
                        for (int j = 0; j < 4; ++j) { v0[j] = sigmoidf_(v0[j] * pre); v1[j] = sigmoidf_(v1[j] * pre); } }
                    if (ACT == 1) {
                        unsigned lo = 0u, hi = 0u;
#pragma unroll
                        for (int j = 0; j < 4; ++j) { lo |= (unsigned)(v0[j] * 255.f + 0.5f) << (8 * j); hi |= (unsigned)(v1[j] * 255.f + 0.5f) << (8 * j); }
                        *(v2u*)((unsigned char*)O + (size_t)(row0 + ai * 128 + m * 16) * ldc + col0 + bj * 128) = (v2u){lo, hi};
                    } else {
                    v4u w; w.x = pg8::cvt_pk_bf16(v0[0], v0[1]); w.y = pg8::cvt_pk_bf16(v0[2], v0[3]); w.z = pg8::cvt_pk_bf16(v1[0], v1[1]); w.w = pg8::cvt_pk_bf16(v1[2], v1[3]);
                    *(v4u*)(rowp + bj * 128) = w; } } }
    }
};
struct EpiProj {
    static constexpr bool PERM = true;
    bf16* PROJ; const f32x2* ROPE; const f32x2* AX64; const f32x2* AX32; const float* QKG; unsigned* KM; unsigned char* QK8; unsigned char* V8T; unsigned char* QK8B; unsigned char* V8TB;
    __device__ __forceinline__ void operator()(const pg8::f32x4 (&acc)[2][2][4][2], const pg8::Unit& u, int wr, int wc, int fr_, int fq_) const {
        const int ln_ = opq(lane_id()), fr = ln_ & 15, fq = ln_ >> 4;
        const int hs = 4 * u.pn + wc;
        int kind = 0, kmi = -1; float scale = 1.f; const float* gp = QKG;
        if (hs < 4) { kind = 1; scale = C2A; } else if (hs < 6) { kind = 1; gp = QKG + 64; }
        else if (hs >= 8 && hs < 12) { kind = 2; scale = C2B; } else if (hs >= 12 && hs < 16) { kind = 2; kmi = 2 + 2 * (hs - 12); }
        else if (hs >= 20 && hs < 24) { kind = 3; scale = C2A; } else if (hs >= 24 && hs < 26) { kind = 3; kmi = 10 + hs - 24; }
        else if (hs >= 28 && hs < 32) { kind = 4; } else if (hs >= 32 && hs < 36) { kind = 4; scale = 0.125f; }
        const int b = u.pm >= PANB ? 1 : 0;
        pg8::f32x4 g[2][2];
#pragma unroll
        for (int bj = 0; bj < 2; ++bj)
#pragma unroll
            for (int n = 0; n < 2; ++n) g[bj][n] = kind == 1 ? *(const pg8::f32x4*)(gp + 32 * bj + 8 * fq + 4 * n) : (pg8::f32x4){1.f, 1.f, 1.f, 1.f};
        float kmx0 = 0.f, kmx1 = 0.f;
#pragma unroll
        for (int ai = 0; ai < 2; ++ai)
#pragma unroll
            for (int m = 0; m < 4; ++m) {
                const int r = u.pm * 256 + ai * 128 + wr * 64 + m * 16 + fr, t = r - b * TB; const bool lat = t >= CTX; const int nl = lat ? t - CTX : 0, prow = nl >> 6, pcol = nl & 63;
                pg8::f32x4 x[2][2];
#pragma unroll
                for (int bj = 0; bj < 2; ++bj)
#pragma unroll
                    for (int n = 0; n < 2; ++n) x[bj][n] = acc[ai][bj][m][n] * (1.f / 32.f);
                if (kind == 1) {
                    float ss = 0.f;
#pragma unroll
                    for (int bj = 0; bj < 2; ++bj)
#pragma unroll
                        for (int n = 0; n < 2; ++n) ss += (x[bj][n][0] * x[bj][n][0] + x[bj][n][1] * x[bj][n][1]) + (x[bj][n][2] * x[bj][n][2] + x[bj][n][3] * x[bj][n][3]);
                    ss += lane_xor<16>(ss); ss += lane_xor<32>(ss);
                    const float rs = __builtin_amdgcn_rsqf(ss * (1.f / 64.f) + 1e-6f);
#pragma unroll
                    for (int bj = 0; bj < 2; ++bj)
#pragma unroll
                        for (int n = 0; n < 2; ++n) x[bj][n] = x[bj][n] * rs * g[bj][n];
                }
                if ((kind == 1 || kind == 3) && lat) {
                    const bool hh = fq >> 1;
#pragma unroll
                    for (int bj = 0; bj < 2; ++bj)
#pragma unroll
                        for (int n = 0; n < 2; ++n) { const f32x4* cp = (const f32x4*)(AX64 + (bj ? pcol : prow) * 16 + 8 * (fq & 1) + 4 * n); const f32x4 c01 = cp[0], c23 = cp[1];
                            const float cc[4] = {c01.x, c01.z, c23.x, c23.z}, sn[4] = {c01.y, c01.w, c23.y, c23.w};
#pragma unroll
                            for (int i = 0; i < 4; ++i) { const float xv = x[bj][n][i], xp = lane_xor<32>(xv); x[bj][n][i] = hh ? xv * cc[i] + xp * sn[i] : xv * cc[i] - xp * sn[i]; } }
                }
                if (kind == 2 && lat) {
                    const bool hh = fq & 1; const int pos = (fq >> 1) ? pcol : prow;
#pragma unroll
                    for (int n = 0; n < 2; ++n) { const f32x4* cp = (const f32x4*)(AX32 + pos * 8 + 4 * n); const f32x4 c01 = cp[0], c23 = cp[1];
                        const float cc[4] = {c01.x, c01.z, c23.x, c23.z}, sn[4] = {c01.y, c01.w, c23.y, c23.w};
#pragma unroll
                        for (int bj = 0; bj < 2; ++bj)
#pragma unroll
                            for (int i = 0; i < 4; ++i) { const float xv = x[bj][n][i], xp = lane_xor<16>(xv); x[bj][n][i] = hh ? xv * cc[i] + xp * sn[i] : xv * cc[i] - xp * sn[i]; } }
                }
                if (kind == 4) {
#pragma unroll
                    for (int n = 0; n < 2; ++n) { const f32x4* cp = (const f32x4*)(ROPE + (size_t)t * 32 + 8 * fq + 4 * n); const f32x4 c01 = cp[0], c23 = cp[1];
                        const float cc[4] = {c01.x, c01.z, c23.x, c23.z}, sn[4] = {c01.y, c01.w, c23.y, c23.w};
#pragma unroll
                        for (int i = 0; i < 4; ++i) { const float x1 = x[0][n][i], x2 = x[1][n][i]; x[0][n][i] = x1 * cc[i] - x2 * sn[i]; x[1][n][i] = x2 * cc[i] + x1 * sn[i]; } }
                }
                bf16* rowp = PROJ + (size_t)r * MIXC + 64 * hs + 8 * fq;
#pragma unroll
                for (int bj = 0; bj < 2; ++bj) { const pg8::f32x4 v0 = x[bj][0] * scale, v1 = x[bj][1] * scale;
                    v4u w; w.x = pg8::cvt_pk_bf16(v0[0], v0[1]); w.y = pg8::cvt_pk_bf16(v0[2], v0[3]); w.z = pg8::cvt_pk_bf16(v1[0], v1[1]); w.w = pg8::cvt_pk_bf16(v1[2], v1[3]);
                    *(v4u*)(rowp + 32 * bj) = w;
                    if (hs == 6 || hs == 7 || (hs >= 16 && hs < 20)) {
                        const int u6 = t & 63, w5 = u6 & 31, pos = 32 * ((w5 >> 2) & 1) + 16 * (u6 >> 5) + (w5 & 3) + 4 * (w5 >> 3);
                        unsigned char* vt = (hs < 8 ? V8T + (size_t)((b * 2 + (hs - 6)) * 64) * attn_body::VTP : V8TB + (size_t)((b * 4 + (hs - 16)) * 64) * attn_body::VTP) + (size_t)(32 * bj + 8 * fq) * attn_body::VTP + (size_t)(t >> 6) * 64 + pos;
                        const int p0 = __builtin_amdgcn_cvt_pk_fp8_f32(v0[0], v0[1], 0, false), p1 = __builtin_amdgcn_cvt_pk_fp8_f32(v0[2], v0[3], 0, false);
                        const int p2 = __builtin_amdgcn_cvt_pk_fp8_f32(v1[0], v1[1], 0, false), p3 = __builtin_amdgcn_cvt_pk_fp8_f32(v1[2], v1[3], 0, false);
                        vt[0] = (unsigned char)p0; vt[attn_body::VTP] = (unsigned char)(p0 >> 8); vt[2 * attn_body::VTP] = (unsigned char)p1; vt[3 * attn_body::VTP] = (unsigned char)(p1 >> 8);
                        vt[4 * attn_body::VTP] = (unsigned char)p2; vt[5 * attn_body::VTP] = (unsigned char)(p2 >> 8); vt[6 * attn_body::VTP] = (unsigned char)p3; vt[7 * attn_body::VTP] = (unsigned char)(p3 >> 8); }
                    if (kind == 1 || kind == 2) {
                        int p0 = __builtin_amdgcn_cvt_pk_fp8_f32(v0[0], v0[1], 0, false); p0 = __builtin_amdgcn_cvt_pk_fp8_f32(v0[2], v0[3], p0, true);
                        int p1 = __builtin_amdgcn_cvt_pk_fp8_f32(v1[0], v1[1], 0, false); p1 = __builtin_amdgcn_cvt_pk_fp8_f32(v1[2], v1[3], p1, true);
                        unsigned char* qd = kind == 1 ? QK8 + (size_t)r * attn_body::QK8P + 64 * hs : QK8B + (size_t)r * 512 + 64 * (hs - 8);
                        *(v2u*)(qd + 32 * bj + 8 * fq) = (v2u){(unsigned)p0, (unsigned)p1}; }
                    if (kmi >= 0) {
                        float mq = 0.f;
                        if (kind == 2) {
#pragma unroll
                            for (int j = 0; j < 4; ++j) { const float a = bflo(w[j]), c = bfhi(w[j]); mq += a * a + c * c; }
                            mq += lane_xor<16>(mq); mq += lane_xor<32>(mq);
                        } else {
#pragma unroll
                        for (int j = 0; j < 4; ++j) { const float a = bflo(w[j]), c = bfhi(w[j]); mq = fmaxf(mq, fmaxf(a * a, c * c)); } }
                        if (bj == 0) kmx0 = fmaxf(kmx0, mq); else kmx1 = fmaxf(kmx1, mq); } }
            }
        if (kmi >= 0) {
            if (kind == 2) { const float m0 = wave_max(kmx0) * 1.15f, m1 = wave_max(kmx1) * 1.15f;     if (ln_ == 0) { atomicMax(KM + kmi, __builtin_bit_cast(unsigned, m0)); atomicMax(KM + kmi + 1, __builtin_bit_cast(unsigned, m1)); } }
            else { const float m0 = wave_max(fmaxf(kmx0, kmx1)) * 64.f; if (ln_ == 0) atomicMax(KM + kmi, __builtin_bit_cast(unsigned, m0)); }
        }
    }
};
struct EpiMerge {
    static constexpr bool PERM = true;
    const unsigned char* G; bf16* Mc; int first; unsigned char* M8; float pre;
    __device__ __forceinline__ void operator()(const pg8::f32x4 (&acc)[2][2][4][2], const pg8::Unit& u, int wr, int wc, int fr_, int fq_) const {
        const int ln_ = opq(lane_id()), fr = ln_ & 15, fq = ln_ >> 4;
        const unsigned row0 = u.pm * 256 + wr * 64 + fr, col0 = u.pn * 256 + wc * 32 + 8 * fq;
        const char* Gb = (const char*)G; char* Mb = (char*)Mc;
#pragma unroll
        for (int ai = 0; ai < 2; ++ai) { const int mb = 0;
            v2u g[4][2]; v4u mo[4][2];
#pragma unroll
            for (int m = mb; m < mb + 4; ++m)
#pragma unroll
                for (int bj = 0; bj < 2; ++bj) { const unsigned r = row0 + ai * 128 + m * 16, c = col0 + bj * 128;
                    g[m][bj] = *(const v2u*)(Gb + (size_t)(r * GATEC + c));
                    mo[m][bj] = first ? (v4u){0u, 0u, 0u, 0u} : *(const v4u*)(Mb + (size_t)(r * DM + c) * 2u); }
#pragma unroll
            for (int m = mb; m < mb + 4; ++m)
#pragma unroll
                for (int bj = 0; bj < 2; ++bj) { const unsigned r = row0 + ai * 128 + m * 16, c = col0 + bj * 128;
                    const pg8::f32x4 v0 = acc[ai][bj][m][0] * pre, v1 = acc[ai][bj][m][1] * pre; const v2u gg = g[m][bj]; const v4u mm = mo[m][bj];
                    v4u w;
                    w.x = pg8::cvt_pk_bf16(bflo(mm.x) + (float)(gg.x & 0xffu) * v0[0], bfhi(mm.x) + (float)((gg.x >> 8) & 0xffu) * v0[1]);
                    w.y = pg8::cvt_pk_bf16(bflo(mm.y) + (float)((gg.x >> 16) & 0xffu) * v0[2], bfhi(mm.y) + (float)(gg.x >> 24) * v0[3]);
                    w.z = pg8::cvt_pk_bf16(bflo(mm.z) + (float)(gg.y & 0xffu) * v1[0], bfhi(mm.z) + (float)((gg.y >> 8) & 0xffu) * v1[1]);
                    w.w = pg8::cvt_pk_bf16(bflo(mm.w) + (float)((gg.y >> 16) & 0xffu) * v1[2], bfhi(mm.w) + (float)(gg.y >> 24) * v1[3]);
                    if (M8) { int p0 = __builtin_amdgcn_cvt_pk_fp8_f32(bflo(w.x), bfhi(w.x), 0, false); p0 = __builtin_amdgcn_cvt_pk_fp8_f32(bflo(w.y), bfhi(w.y), p0, true);
                              int p1 = __builtin_amdgcn_cvt_pk_fp8_f32(bflo(w.z), bfhi(w.z), 0, false); p1 = __builtin_amdgcn_cvt_pk_fp8_f32(bflo(w.w), bfhi(w.w), p1, true);
                              *(v2u*)(M8 + (size_t)r * DM + c) = (v2u){(unsigned)p0, (unsigned)p1}; }
                    else *(v4u*)(Mb + (size_t)(r * DM + c) * 2u) = w; }
        }
    }
};
struct EpiQ8 {
    static constexpr bool PERM = true;
    bf16* O; int ldc; const float* SXr; const float* SWc;
    __device__ __forceinline__ void operator()(const pg8::f32x4 (&acc)[2][2][4][2], const pg8::Unit& u, int wr, int wc, int fr_, int fq_) const {
        typedef int i32x4_ __attribute__((ext_vector_type(4)));
        const int ln_ = opq(lane_id()), fr = ln_ & 15, fq = ln_ >> 4;
        const int row0 = u.pm * 256 + wr * 64 + fr, col0 = u.pn * 256 + wc * 32 + 8 * fq;
#pragma unroll
        for (int bj = 0; bj < 2; ++bj) { const pg8::f32x4 s0 = *(const pg8::f32x4*)(SWc + col0 + bj * 128), s1 = *(const pg8::f32x4*)(SWc + col0 + bj * 128 + 4);
#pragma unroll
            for (int ai = 0; ai < 2; ++ai)
#pragma unroll
                for (int m = 0; m < 4; ++m) { const int r = row0 + ai * 128 + m * 16; const float sx = SXr[r];
                    const i32x4_ a0 = __builtin_bit_cast(i32x4_, acc[ai][bj][m][0]), a1 = __builtin_bit_cast(i32x4_, acc[ai][bj][m][1]);
                    v4u w; w.x = pg8::cvt_pk_bf16((float)a0[0] * sx * s0[0], (float)a0[1] * sx * s0[1]); w.y = pg8::cvt_pk_bf16((float)a0[2] * sx * s0[2], (float)a0[3] * sx * s0[3]);
                    w.z = pg8::cvt_pk_bf16((float)a1[0] * sx * s1[0], (float)a1[1] * sx * s1[1]); w.w = pg8::cvt_pk_bf16((float)a1[2] * sx * s1[2], (float)a1[3] * sx * s1[3]);
                    *(v4u*)(O + (size_t)r * ldc + col0 + bj * 128) = w; } }
    }
};
struct EpiOut {
    static constexpr bool PERM = true;
    float* Hlat; float* Hctx; const float* MODl; float pre;
    __device__ __forceinline__ void operator()(const pg8::f32x4 (&acc)[2][2][4][2], const pg8::Unit& u, int wr, int wc, int fr_, int fq_) const {
        const int ln_ = opq(lane_id()), fr = ln_ & 15, fq = ln_ >> 4;
        const int b = u.pm >= PANB ? 1 : 0, pc = u.pm - b * PANB; const bool isctx = pc == 0;
        float* base = isctx ? Hctx + (size_t)b * CTX * DM : Hlat + ((size_t)b * SEQ + (size_t)(pc - 1) * 256) * DM;
        const float* gate = MODl + (size_t)(isctx ? 2 : b) * 6144 + 2 * DM;
        const int rl0 = wr * 64 + fr, col0 = u.pn * 256 + wc * 32 + 8 * fq;
#pragma unroll
        for (int bj = 0; bj < 2; ++bj) { const int c = col0 + bj * 128;
            const pg8::f32x4 g0 = *(const pg8::f32x4*)(gate + c), g1 = *(const pg8::f32x4*)(gate + c + 4);
#pragma unroll
            for (int ai = 0; ai < 2; ++ai)
#pragma unroll
                for (int m = 0; m < 4; ++m) { float* p = base + (size_t)(rl0 + ai * 128 + m * 16) * DM + c;
                    const pg8::f32x4 h0 = *(const pg8::f32x4*)p, h1 = *(const pg8::f32x4*)(p + 4);
                    *(pg8::f32x4*)p = h0 * ALPHA + g0 * (acc[ai][bj][m][0] * pre);
                    *(pg8::f32x4*)(p + 4) = h1 * ALPHA + g1 * (acc[ai][bj][m][1] * pre); } }
    }
};

__device__ __forceinline__ void ph_ln1(const Params& P, const Ctx& F, int l, bool last) {
    const float* MOD = (const float*)(F.ws + WS_MOD) + (size_t)l * 3 * 6144;
    const float* lg = P.in[I_LNA] + (size_t)l * 2 * DM; const float* lb = lg + DM;
    for (int n = F.gw; n < PQC; n += F.NGW) {
        const bf16* wrow = (const bf16*)(F.ws + WS_WQ) + (size_t)n * DM + 16 * F.lane;
        const v4u w0 = *(const v4u*)wrow, w1 = *(const v4u*)(wrow + 8);
        float f[16]; f[0] = bflo(w0.x); f[1] = bfhi(w0.x); f[2] = bflo(w0.y); f[3] = bfhi(w0.y); f[4] = bflo(w0.z); f[5] = bfhi(w0.z); f[6] = bflo(w0.w); f[7] = bfhi(w0.w);
        f[8] = bflo(w1.x); f[9] = bfhi(w1.x); f[10] = bflo(w1.y); f[11] = bfhi(w1.y); f[12] = bflo(w1.z); f[13] = bfhi(w1.z); f[14] = bflo(w1.w); f[15] = bfhi(w1.w);
        float mx = 0.f;
#pragma unroll
        for (int j = 0; j < 16; ++j) mx = fmaxf(mx, fabsf(f[j]));
        mx = wave_max(mx);
        const float sw = fmaxf(mx, 1e-30f) * (1.f / 127.f), isw = 1.f / sw;
        v4u q;
#pragma unroll
        for (int g = 0; g < 4; ++g) { unsigned w = 0;
#pragma unroll
            for (int k = 0; k < 4; ++k) { const int qi = (int)rintf(f[4 * g + k] * isw); w |= (unsigned)(qi & 0xff) << (8 * k); }
            q[g] = w; }
        *(v4u*)(F.ws + WS_WQ8 + (size_t)n * DM + 16 * F.lane) = q;
        if (F.lane == 0) ((float*)(F.ws + WS_SWQ))[n] = sw;
    }
    for (int r = F.gw; r < MROWS; r += F.NGW) {
        const int b = r >= TB ? 1 : 0, t = r - b * TB; if (last && t < CTX) continue;
        float* hp = hrow(P, r);
        const float* m = MOD + (size_t)(t < CTX ? 2 : b) * 6144;
        f32x4 v[4]; float s = 0.f;
#pragma unroll
        for (int j = 0; j < 4; ++j) { v[j] = *(const f32x4*)(hp + 4 * F.lane + 256 * j); s += (v[j].x + v[j].y) + (v[j].z + v[j].w); }
        const float mean = wave_sum(s) * (1.f / DM); float s2 = 0.f;
#pragma unroll
        for (int j = 0; j < 4; ++j) { v[j] = v[j] - mean; s2 += (v[j].x * v[j].x + v[j].y * v[j].y) + (v[j].z * v[j].z + v[j].w * v[j].w); }
        const float rstd = __builtin_amdgcn_rsqf(wave_sum(s2) * (1.f / DM) + 1e-5f);
#pragma unroll
        for (int j = 0; j < 4; ++j) { const int c = 4 * F.lane + 256 * j;
            const f32x4 h = v[j] * rstd * *(const f32x4*)(lg + c) + *(const f32x4*)(lb + c);
            const f32x4 u = h * (*(const f32x4*)(m + 4 * DM + c) + 1.f) + *(const f32x4*)(m + 3 * DM + c);
            v[j] = u; }
        float mx = 0.f;
#pragma unroll
        for (int j = 0; j < 4; ++j) mx = fmaxf(mx, fmaxf(fmaxf(fabsf(v[j].x), fabsf(v[j].y)), fmaxf(fabsf(v[j].z), fabsf(v[j].w))));
        mx = wave_max(mx);
        const float sx = fmaxf(mx, 1e-30f) * (1.f / 127.f), isx = 1.f / sx;
#pragma unroll
        for (int j = 0; j < 4; ++j) { unsigned w = 0;
#pragma unroll
            for (int k = 0; k < 4; ++k) { const int q = (int)rintf(v[j][k] * isx); w |= (unsigned)(q & 0xff) << (8 * k); }
            *(unsigned*)(F.ws + WS_XQ + (size_t)r * DM + 4 * F.lane + 256 * j) = w; }
        if (F.lane == 0) { ((float*)(F.ws + WS_SX))[r] = sx; ((f32x2*)(F.ws + WS_ST))[r] = (f32x2){mean, rstd}; }
    }
}

__device__ __forceinline__ int f2sort(float x) { const int b = __builtin_bit_cast(int, x); return b ^ ((b >> 31) & 0x7fffffff); }
__device__ __forceinline__ float sort2f(int s) { return __builtin_bit_cast(float, s ^ ((s >> 31) & 0x7fffffff)); }
__device__ __forceinline__ int imax3(int a, int b, int c) { return max(max(a, b), c); }
#define CE_DESC(x, y) do { const int hi__ = max((x), (y)), lo__ = min((x), (y)); (x) = hi__; (y) = lo__; } while (0)
__device__ __forceinline__ void sort16_desc(int* v) {
#pragma unroll
    for (int k = 2; k <= 16; k <<= 1)
#pragma unroll
        for (int j = k >> 1; j >= 1; j >>= 1)
#pragma unroll
            for (int i = 0; i < 16; ++i) { const int p = i ^ j; if (p > i) { if ((i & k) == 0) CE_DESC(v[i], v[p]); else CE_DESC(v[p], v[i]); } }
}
__device__ __forceinline__ void merge16_desc(int* a, const int* b) {
#pragma unroll
    for (int i = 0; i < 16; ++i) a[i] = max(a[i], b[15 - i]);
#pragma unroll
    for (int st = 8; st >= 1; st >>= 1)
#pragma unroll
        for (int i = 0; i < 16; ++i) if ((i & st) == 0) CE_DESC(a[i], a[i | st]);
}
__device__ __forceinline__ void ph_topk(const Params& P, const Ctx& F, bool last) {
    const bf16* QP = (const bf16*)(F.ws + WS_BIG); const bf16* SK = (const bf16*)(F.ws + WS_SK); int2* SEL = (int2*)(F.ws + WS_SEL);
    LAS unsigned char* SKs = F.lds;
    LAS int* LA = (LAS int*)(F.lds + 36864 + F.wave * 12288);
    const int lane = F.lane, r32 = lane & 31, hi = lane >> 5;
    constexpr int IMIN = -2147483647 - 1;
    for (int u = F.vcu; u < (last ? 128 : NPAN) * 8; u += F.G) {
        int pan = u >> 3; const int hd = u & 7; if (last) pan += 1 + (pan >= 64 ? 1 : 0); const size_t row = (size_t)pan * 256 + F.wave * 32 + r32;
        for (int p = 0; p < 2; ++p) {
            __syncthreads();
#pragma unroll
            for (int i = 0; i < 4; ++i) { const int idx = F.tid + NTHR * i, rr = idx >> 4, ch = idx & 15;
                *(LAS v4u*)(SKs + rr * 272 + ch * 16) = *(const v4u*)(SK + ((size_t)(hd * 2 + p) * 128 + rr) * 128 + ch * 8); }
            bf16x8 qf[8];
#pragma unroll
            for (int s = 0; s < 8; ++s) qf[s] = *reinterpret_cast<const bf16x8*>(QP + row * PQC + hd * 256 + p * 128 + 64 * hi + 8 * s);
            __syncthreads();
            int v[64];
#pragma unroll
            for (int nb = 0; nb < 4; ++nb) { f32x16 acc = zero16();
#pragma unroll
                for (int s = 0; s < 8; ++s) { const bf16x8 a = *(const LAS bf16x8*)(SKs + (32 * nb + r32) * 272 + (64 * hi + 8 * s) * 2);
                    acc = __builtin_amdgcn_mfma_f32_32x32x16_bf16(a, qf[s], acc, 0, 0, 0); }
#pragma unroll
                for (int i = 0; i < 16; ++i) v[nb * 16 + i] = (f2sort(acc[i]) & ~127) | (32 * nb + (i & 3) + 8 * (i >> 2) + 4 * hi); }
            LAS int* la = LA + p * 1024;
            sort16_desc(v); sort16_desc(v + 16); sort16_desc(v + 32); sort16_desc(v + 48);
            merge16_desc(v, v + 16); merge16_desc(v + 32, v + 48); merge16_desc(v, v + 32);
#pragma unroll
            for (int it = 0; it < 16; ++it) la[it * 64 + lane] = v[it];
        }
        LDS_WAIT();
        int c[16];
        { LAS int* la = LA + hi * 1024;
#pragma unroll
            for (int i = 0; i < 16; ++i) c[i] = max(la[i * 64 + lane], la[(15 - i) * 64 + (lane ^ 32)]);
#pragma unroll
            for (int st = 8; st >= 1; st >>= 1)
#pragma unroll
                for (int i = 0; i < 16; ++i) if ((i & st) == 0) { const int hi_ = max(c[i], c[i | st]), lo_ = min(c[i], c[i | st]); c[i] = hi_; c[i | st] = lo_; }
#pragma unroll
            for (int i = 0; i < 16; ++i) LA[2048 + i * 64 + lane] = c[i]; }
        LDS_WAIT();
        int ck[27], ce[27];
        { int Pl[16], Ql[16];
#pragma unroll
            for (int i = 0; i < 16; ++i) { Pl[i] = LA[2048 + i * 64 + lane]; Ql[i] = LA[2048 + i * 64 + (lane ^ 32)]; }
            int n = 0;
#pragma unroll
            for (int a = 0; a < 16; ++a)
#pragma unroll
                for (int b = a; b < 16; ++b) if ((a + 1) * (b + 1) <= 16) {
                    const float sum = sort2f(Pl[a] & ~127) + sort2f(Ql[b] & ~127);
                    const int ip = Pl[a] & 127, iq = Ql[b] & 127;
                    int key = (f2sort(sum) & ~31) | n;
                    if (a == b && hi) key = IMIN;
                    ck[n] = key; ce[n] = hi ? (iq * 128 + ip) : (ip * 128 + iq); ++n; } }
        LAS int* CK = LA + 2048; LAS int* CE = LA;
        {
            int kk2[32];
#pragma unroll
            for (int k = 0; k < 27; ++k) { kk2[k] = ck[k]; LA[k * 64 + lane] = ce[k]; }
#pragma unroll
            for (int k = 27; k < 32; ++k) kk2[k] = IMIN;
            sort16_desc(kk2); sort16_desc(kk2 + 16); merge16_desc(kk2, kk2 + 16);
            LDS_WAIT();
            int we[16];
#pragma unroll
            for (int it = 0; it < 16; ++it) we[it] = LA[(kk2[it] & 31) * 64 + lane];
            LDS_WAIT();
#pragma unroll
            for (int it = 0; it < 16; ++it) { CK[it * 64 + lane] = kk2[it]; CE[it * 64 + lane] = we[it]; }
        }
        LDS_WAIT();
        float fv[16]; int fe[16]; float mx = -INFINITY;
#pragma unroll
        for (int i = 0; i < 16; ++i) { const int k0 = CK[i * 64 + lane], k1 = CK[(15 - i) * 64 + (lane ^ 32)]; const int e0 = CE[i * 64 + lane], e1 = CE[(15 - i) * 64 + (lane ^ 32)];
            const bool t0 = k0 >= k1; fe[i] = t0 ? e0 : e1; fv[i] = sort2f((t0 ? k0 : k1) & ~31); mx = fmaxf(mx, fv[i]); }
        float den = 0.f;
#pragma unroll
        for (int i = 0; i < 16; ++i) { fv[i] = __expf(fv[i] - mx); den += fv[i]; }
        const float rden = 1.f / den;
        int2* dst = SEL + (row * 8 + hd) * 16 + hi * 8;
#pragma unroll
        for (int i = 0; i < 8; ++i) dst[i] = make_int2(fe[i], __builtin_bit_cast(int, fv[i] * rden));
    }
    __syncthreads();
}

__device__ __forceinline__ float gelu_tanh(float x) { const float t = 1.5957691216057308f * (x + 0.044715f * x * x * x); return x * __builtin_amdgcn_rcpf(1.f + __expf(-t)); }
__device__ __forceinline__ void ph_peer_u(const Params& P, const Ctx& F, bool last) {
    const unsigned char* PU = F.ws + WS_PU; const float* SU = (const float*)(F.ws + WS_SU);
    const int2* SEL = (const int2*)(F.ws + WS_SEL); float* DOT = (float*)(F.ws + WS_DOT);
    const unsigned char* XQ = F.ws + WS_XQ; const float* SX = (const float*)(F.ws + WS_SX);
    const int lane = F.lane, g4 = lane >> 4, t16 = lane & 15;
    int S = 1, s = 0, nx = F.G, myrank = F.bx;
    if ((F.G & 7) == 0) { S = 8; s = F.bx & 7; nx = F.G >> 3; myrank = F.bx >> 3; }
    LAS int* SL = (LAS int*)(F.lds + F.wave * 2048);
    const int stride = nx * NWAVES;
    const unsigned long long lt = (1ull << lane) - 1ull;
#define PEERU_SKIP(rr) do { if (last) { while ((rr) < MROWS && ((rr) - ((rr) >= TB ? TB : 0)) < CTX) (rr) += stride; } } while (0)
#define PEERU_LOADSEL(rr, A0, A1) do { const int rc_ = (rr) < MROWS ? (rr) : MROWS - 1; A0 = SEL[(size_t)rc_ * 128 + lane]; A1 = SEL[(size_t)rc_ * 128 + 64 + lane]; } while (0)
#define PEERU_LOADX(rr, AX, AS) do { const int rc_ = (rr) < MROWS ? (rr) : MROWS - 1; \
        _Pragma("unroll") for (int j_ = 0; j_ < 4; ++j_) AX[j_] = *(const v4u*)(XQ + (size_t)rc_ * DM + 256 * j_ + 16 * t16); AS = SX[rc_]; } while (0)
#define PEERU_COMPACT(buf, A0, A1, CNT) do { LAS int* sle_ = SL + (buf) * 256; const bool i0_ = (((A0).x * S) >> 14) == s, i1_ = (((A1).x * S) >> 14) == s; \
        const unsigned long long m0_ = __ballot(i0_), m1_ = __ballot(i1_); const int c0_ = __popcll(m0_); CNT = c0_ + __popcll(m1_); \
        if (i0_) { const int k_ = __popcll(m0_ & lt); sle_[k_] = (A0).x; sle_[128 + k_] = lane; } \
        if (i1_) { const int k_ = c0_ + __popcll(m1_ & lt); sle_[k_] = (A1).x; sle_[128 + k_] = 64 + lane; } } while (0)
#define PEERU_ROWS(UA, SUA, buf, base, CNT) do { if ((CNT) > (base)) { const LAS int* sle_ = SL + (buf) * 256; \
        _Pragma("unroll") for (int s_ = 0; s_ < 4; ++s_) { if (s_ > 0 && (base) + 4 * s_ >= (CNT)) break;        \
            const int li_ = (base) + 4 * s_ + g4; const int e_ = sle_[li_ < (CNT) ? li_ : (CNT) - 1]; SUA[s_] = SU[e_]; \
            const unsigned ro_ = (unsigned)e_ * (unsigned)DM + 16u * (unsigned)t16; \
            _Pragma("unroll") for (int j_ = 0; j_ < 4; ++j_) UA[4 * s_ + j_] = *(const v4u*)(PU + ro_ + 256 * j_); } } } while (0)
#define PEERU_ROWS0(UA, SUA, buf, CNT) do { const LAS int* sle_ = SL + (buf) * 256; const int lim_ = (CNT) > 0 ? (CNT) - 1 : 0;     \
        _Pragma("unroll") for (int s_ = 0; s_ < 4; ++s_) { const int li_ = 4 * s_ + g4; const int e_ = sle_[li_ < lim_ ? li_ : lim_] & (NEXP - 1); SUA[s_] = SU[e_]; \
            const unsigned ro_ = (unsigned)e_ * (unsigned)DM + 16u * (unsigned)t16; \
            _Pragma("unroll") for (int j_ = 0; j_ < 4; ++j_) UA[4 * s_ + j_] = *(const v4u*)(PU + ro_ + 256 * j_); } } while (0)
#define PEERU_DOTS(UA, XA) do { _Pragma("unroll") for (int s_ = 0; s_ < 4; ++s_) { int sd_ = 0; \
        _Pragma("unroll") for (int j_ = 0; j_ < 4; ++j_) { sd_ = __builtin_amdgcn_sdot4((int)UA[4 * s_ + j_].x, (int)XA[j_].x, sd_, false); sd_ = __builtin_amdgcn_sdot4((int)UA[4 * s_ + j_].y, (int)XA[j_].y, sd_, false); \
            sd_ = __builtin_amdgcn_sdot4((int)UA[4 * s_ + j_].z, (int)XA[j_].z, sd_, false); sd_ = __builtin_amdgcn_sdot4((int)UA[4 * s_ + j_].w, (int)XA[j_].w, sd_, false); } d[s_] = sd_; } } while (0)
#define PEERU_REDUCE_STORE(buf, base, CNT, RR, SXV, SUA) do { const LAS int* sle_ = SL + (buf) * 256; float f_[4]; \
        _Pragma("unroll") for (int s_ = 0; s_ < 4; ++s_) f_[s_] = (float)d[s_] * SUA[s_]; \
        _Pragma("unroll") for (int i = 0; i < 2; ++i) { const bool up = lane & 8; const float send = up ? f_[i] : f_[i + 2], keep = up ? f_[i + 2] : f_[i]; f_[i] = keep + lane_xor<8>(send); } \
        { const bool up = lane & 4; const float send = up ? f_[0] : f_[1], keep = up ? f_[1] : f_[0]; f_[0] = keep + lane_xor<4>(send); } \
        f_[0] += lane_xor<2>(f_[0]); f_[0] += lane_xor<1>(f_[0]); \
        const int my_ = (base) + 4 * (((lane >> 3) & 1) * 2 + ((lane >> 2) & 1)) + g4; \
        if (my_ < (CNT) && (lane & 3) == 0) { const int ei_ = sle_[128 + my_]; DOT[(size_t)(RR) * 128 + ei_] = f_[0] * (SXV); } } while (0)
    int r = myrank * NWAVES + F.wave; PEERU_SKIP(r);
    if (r >= MROWS) return;
    int rn = r + stride; PEERU_SKIP(rn);
    int2 e0, e1, n0, n1; v4u xqA[4], xqB[4]; float sxA, sxB = 0.f; int cnt, cntn = 0;
    v4u ua[16]; float suc[4] = {0.f, 0.f, 0.f, 0.f};
#pragma unroll
    for (int k = 0; k < 16; ++k) ua[k] = (v4u){0u, 0u, 0u, 0u};
#pragma unroll
    for (int k = 0; k < 4; ++k) xqB[k] = (v4u){0u, 0u, 0u, 0u};
    v4u ub[16];
#pragma unroll
    for (int k = 0; k < 16; ++k) ub[k] = (v4u){0u, 0u, 0u, 0u};
    PEERU_LOADSEL(r, e0, e1); PEERU_LOADX(r, xqA, sxA);
    PEERU_LOADSEL(rn, n0, n1);
    PEERU_COMPACT(0, e0, e1, cnt);
    LDS_WAIT();
    PEERU_ROWS0(ua, suc, 0, cnt);
#define PEERU_ITER(CB, XC, SXC, XN, SXN) { \
        int rn2 = rn + stride; PEERU_SKIP(rn2); \
        int2 p0, p1; PEERU_LOADSEL(rn2, p0, p1);                 \
        PEERU_LOADX(rn, XN, SXN);                                \
        PEERU_COMPACT((CB) ^ 1, n0, n1, cntn);                   \
        LDS_WAIT(); \
        int d[4]; float sud[4]; \
        _Pragma("unroll") for (int k = 0; k < 4; ++k) sud[k] = suc[k]; \
        PEERU_DOTS(ua, XC);                                      \
        PEERU_ROWS0(ua, suc, (CB) ^ 1, cntn);                    \
        PEERU_REDUCE_STORE(CB, 0, cnt, r, SXC, sud); \
        if (cnt > 16) {                                          \
            float su2[4] = {0.f, 0.f, 0.f, 0.f}; \
            for (int base = 16; base < cnt; base += 16) { \
                PEERU_ROWS(ub, su2, CB, base, cnt); \
                PEERU_DOTS(ub, XC); \
                PEERU_REDUCE_STORE(CB, base, cnt, r, SXC, su2); \
            } \
        } \
        LDS_WAIT(); \
        r = rn; rn = rn2; cnt = cntn; n0 = p0; n1 = p1; }
    for (;;) {
        PEERU_ITER(0, xqA, sxA, xqB, sxB);
        if (r >= MROWS) break;
        PEERU_ITER(1, xqB, sxB, xqA, sxA);
        if (r >= MROWS) break;
    }
#undef PEERU_ITER
#undef PEERU_LOADSEL
#undef PEERU_LOADX
#undef PEERU_ROWS0
#undef PEERU_SKIP
#undef PEERU_COMPACT
#undef PEERU_ROWS
#undef PEERU_DOTS
#undef PEERU_REDUCE_STORE
}
__device__ __forceinline__ void ph_peer_v(const Params& P, const Ctx& F, int l, bool last) {
    const unsigned char* PV = F.ws + WS_PV; const float* SV = (const float*)(F.ws + WS_SV);
    const int2* SEL = (const int2*)(F.ws + WS_SEL); const float* DOT = (const float*)(F.ws + WS_DOT);
    const float* MOD = (const float*)(F.ws + WS_MOD);
    const float* lg = P.in[I_LNF] + (size_t)l * 2 * DM; const float* lb = lg + DM;
    const int lane = F.lane;
    for (int r = F.gw; r < MROWS; r += F.NGW) {
        const int b = r >= TB ? 1 : 0, t = r - b * TB;
        if (last && t < CTX) continue;
        f32x2 y2[8];
#pragma unroll
        for (int j = 0; j < 8; ++j) y2[j] = (f32x2){0.f, 0.f};
        const int2* selr = SEL + (size_t)r * 128 + (lane & 15); const float* dotr = DOT + (size_t)r * 128 + (lane & 15);
        int2 ent = selr[0], entn = selr[16], ent2 = selr[32]; float dt = dotr[0], dtn = dotr[16], dt2 = dotr[32];
        v2u va[16], vb[16];
#pragma unroll
        for (int k = 0; k < 16; ++k) va[k] = *(const v2u*)(PV + (size_t)__builtin_amdgcn_readlane(ent.x, k) * (DM / 2) + 8 * lane);
#pragma unroll
        for (int k = 0; k < 16; ++k) vb[k] = *(const v2u*)(PV + (size_t)__builtin_amdgcn_readlane(entn.x, k) * (DM / 2) + 8 * lane);
#define PEERV_HEAD(VA, H3, PF, L3) do { \
            int2 ent3 = ent2; float dt3 = dt2; if (L3) { ent3 = selr[(H3) * 16]; dt3 = dotr[(H3) * 16]; } \
            const float wgt = __builtin_bit_cast(float, ent.y) * gelu_tanh(dt) * SV[ent.x];        \
            _Pragma("unroll") for (int k = 0; k < 16; ++k) { \
                const float w = __builtin_bit_cast(float, __builtin_amdgcn_readlane(__builtin_bit_cast(int, wgt), k)); const f32x2 w2 = (f32x2){w, w}; \
                _Pragma("unroll") for (int d = 0; d < 2; ++d) { const unsigned q = VA[k][d];       \
                    y2[4 * d] = __builtin_elementwise_fma(w2, __builtin_amdgcn_cvt_scalef32_pk_f32_fp4(q, 1.0f, 0), y2[4 * d]); y2[4 * d + 1] = __builtin_elementwise_fma(w2, __builtin_amdgcn_cvt_scalef32_pk_f32_fp4(q, 1.0f, 1), y2[4 * d + 1]); \
                    y2[4 * d + 2] = __builtin_elementwise_fma(w2, __builtin_amdgcn_cvt_scalef32_pk_f32_fp4(q, 1.0f, 2), y2[4 * d + 2]); y2[4 * d + 3] = __builtin_elementwise_fma(w2, __builtin_amdgcn_cvt_scalef32_pk_f32_fp4(q, 1.0f, 3), y2[4 * d + 3]); } \
                if (PF) { VA[k] = *(const v2u*)(PV + (size_t)__builtin_amdgcn_readlane(ent2.x, k) * (DM / 2) + 8 * lane); __builtin_amdgcn_sched_barrier(0); } } \
            ent = entn; dt = dtn; entn = ent2; dtn = dt2; ent2 = ent3; dt2 = dt3; } while (0)
#pragma unroll 1
        for (int hp = 0; hp < 2; ++hp) { PEERV_HEAD(va, 2 * hp + 3, true, true); PEERV_HEAD(vb, 2 * hp + 4, true, true); }
        PEERV_HEAD(va, 7, true, true); PEERV_HEAD(vb, 7, true, false);
        PEERV_HEAD(va, 7, false, false); PEERV_HEAD(vb, 7, false, false);
#undef PEERV_HEAD
        float* hp = hrow(P, r);
        const float* m = MOD + ((size_t)l * 3 + (t < CTX ? 2 : b)) * 6144;
        const f32x2 st = ((const f32x2*)(F.ws + WS_ST))[r]; const float* lga = P.in[I_LNA] + (size_t)l * 2 * DM; const float* lba = lga + DM;
        float v[16]; float s = 0.f;
#pragma unroll
        for (int q = 0; q < 4; ++q) { const int c = 16 * lane + 4 * q;
            const f32x4 hv = *(const f32x4*)(hp + c), g = *(const f32x4*)(m + 5 * DM + c);
            const f32x4 h = (hv - st.x) * st.y * *(const f32x4*)(lga + c) + *(const f32x4*)(lba + c);
#pragma unroll
            for (int j = 0; j < 4; ++j) { v[4 * q + j] = ALPHA * h[j] + g[j] * y2[2 * q + (j >> 1)][j & 1]; s += v[4 * q + j]; } }
        const float mean = wave_sum(s) * (1.f / DM); float s2 = 0.f;
#pragma unroll
        for (int j = 0; j < 16; ++j) { v[j] -= mean; s2 += v[j] * v[j]; }
        const float rstd = __builtin_amdgcn_rsqf(wave_sum(s2) * (1.f / DM) + 1e-5f);
        const float* mn = MOD + ((size_t)(l + 1) * 3 + (t < CTX ? 2 : b)) * 6144;
#pragma unroll
        for (int q = 0; q < 4; ++q) { const int c = 16 * lane + 4 * q;
            const f32x4 gg = *(const f32x4*)(lg + c), bb = *(const f32x4*)(lb + c);
            f32x4 h;
#pragma unroll
            for (int j = 0; j < 4; ++j) h[j] = v[4 * q + j] * rstd * gg[j] + bb[j];
            *(f32x4*)(hp + c) = h;
            if (!last) { const f32x4 u = h * (*(const f32x4*)(mn + DM + c) + 1.f) + *(const f32x4*)(mn + c);
                int w8 = __builtin_amdgcn_cvt_pk_fp8_f32(u.x, u.y, 0, false); w8 = __builtin_amdgcn_cvt_pk_fp8_f32(u.z, u.w, w8, true);
                *(unsigned*)(F.ws + WS_U8 + (size_t)r * DM + c) = (unsigned)w8; } }
    }
}
#ifndef PHSEL
#define PHSEL 0xffffffffu
#endif
#define EN(id) (((PHSEL) >> (id)) & 1u)
#ifndef MK_SPLIT
#define MK_SPLIT 0
#endif
constexpr int NPHASE = 2 + NLAYER * 14;
struct KArgs { Params P; int ph_lo, ph_hi; };
__global__ void __launch_bounds__(NTHR, 2) hybrid_fwd(KArgs A_unused) {
    extern __shared__ __attribute__((aligned(16))) unsigned char lds_raw[];
    const __attribute__((address_space(4))) KArgs& A = *(const __attribute__((address_space(4))) KArgs*)__builtin_amdgcn_kernarg_segment_ptr();
    const Params& P0 = (const Params&)A.P;
    Ctx F0;
    F0.lds = (LAS unsigned char*)lds_raw; F0.ws = P0.ws;
    F0.tid = threadIdx.x; F0.lane = F0.tid & 63; F0.wave = __builtin_amdgcn_readfirstlane(F0.tid >> 6);
    F0.G = gridDim.x; { const int bx = blockIdx.x; F0.vcu = (F0.G % 8 == 0) ? (bx % 8) * (F0.G / 8) + bx / 8 : bx; }
    F0.gw = F0.vcu * NWAVES + F0.wave; F0.NGW = F0.G * NWAVES; F0.bx = blockIdx.x;
    volatile LAS unsigned* MISC = (volatile LAS unsigned*)(F0.lds + MISC_OFF);
    for (int u = F0.tid; u < (LDS_BYTES - MISC_OFF) / 4; u += NTHR) MISC[u] = 0u;
    __syncthreads();
    unsigned* ctl = (unsigned*)(P0.ws + WS_CTL);
    XcdBarrier bar; bar.bar = ctl + CW_BAR; bar.x = 0; bar.st = nullptr; bar.w0 = 0u;
    if (!MK_SPLIT) bar = xcd_barrier_post(ctl + CW_BAR, MISC + 8);
    bar.w0 = F0.wave == 0 ? 1u : 0u;
    const int lo = A.ph_lo, hi = A.ph_hi;
    int ph = 0;
#define PHASE(...) do { if (lo <= ph && ph < hi) { const __attribute__((address_space(4))) KArgs* Ap_ = &A; asm volatile("" : "+s"(Ap_)); const Params& P = (const Params&)Ap_->P; Ctx F = F0; F.wave = opqs(F0.wave); F.G = opqs(F0.G); F.vcu = opqs(F0.vcu); F.bx = opqs(F0.bx); F.gw = F.vcu * NWAVES + F.wave; F.NGW = F.G * NWAVES; F.lane = opq(lane_id()); F.tid = F.wave * 64 + F.lane; F.ws = P.ws; \
        bf16* Ub = (bf16*)(P.ws + WS_U); bf16* OC = (bf16*)(P.ws + WS_OCAT); bf16* BIG = (bf16*)(P.ws + WS_BIG); (void)Ub; (void)OC; (void)BIG; __VA_ARGS__; if (ph + 1 < hi) xcd_barrier(bar); } ++ph; } while (0)
    PHASE(if (EN(0)) ph_tables(P, F));
    for (int l = 0; l < NLAYER; ++l) {
        const bool need_ctx = l + 1 < NLAYER, last = !need_ctx;
        PHASE(if (EN(1)) ph_convert(P, F, l));
        PHASE(if (EN(2) && l == 0) ph_mod0(P, F));
        PHASE(if (EN(3)) { pg8::Gemm g{(const bf16*)(P.ws + WS_U8), (const bf16*)(P.ws + WS_WIN), MROWS, MIXC, DM / 2, DM / 2, DM / 2}; pg8::StaticOrder S; S.init(MROWS, MIXC, F.G, F.bx);
                EpiProj E{BIG, (const f32x2*)(P.ws + WS_ROPE), (const f32x2*)(P.ws + WS_AX64), (const f32x2*)(P.ws + WS_AX32), P.in[I_QKG] + l * 128, (unsigned*)(P.ws + WS_CTL) + CW_KM + l * 12, P.ws + WS_QK8, P.ws + WS_V8T, P.ws + WS_QK8B, P.ws + WS_V8TB};
                pg8::gemm_phase<EpiProj, pg8::StaticOrder, true>(F.lds, g, S, E, F.wave); });
        PHASE(if (EN(5)) ph_ret_kv(P, F, l));
        PHASE(if (EN(6)) ph_ret_scan(P, F, l));
        PHASE(if (EN(7)) ph_mix(P, F, l, need_ctx));
        PHASE(if (EN(8)) { pg8::Gemm g{(const bf16*)(P.ws + WS_U8), (const bf16*)(P.ws + WS_WIN) + (size_t)MIXC * (DM / 2), MROWS, GATEC, DM / 2, DM / 2, DM / 2};
                pg8::StaticOrder S; S.init(MROWS, GATEC, F.G, F.bx, last);
                EpiStore<1> E{BIG, GATEC, 1.f / 32.f}; pg8::gemm_phase<EpiStore<1>, pg8::StaticOrder, true>(F.lds, g, S, E, F.wave); });
        PHASE(if (EN(9)) { for (int i = 0; i < 4; ++i) {
                    pg8::Gemm g{(const bf16*)(P.ws + WS_OCAT + i * 256), (const bf16*)(P.ws + WS_WB + (size_t)i * DM * 256), MROWS, DM, 128, DM / 2, 128}; pg8::StaticOrder S; S.init(MROWS, DM, F.G, F.bx, last);
                    EpiMerge E{(const unsigned char*)BIG + i * DM, Ub, i == 0, i == 3 ? (unsigned char*)(P.ws + WS_U8) : (unsigned char*)nullptr, 1.f / (255.f * 32.f * (i == 1 ? OSC_B : i == 3 ? OSC_D : OSC_AC))};
                    pg8::gemm_phase<EpiMerge, pg8::StaticOrder, true>(F.lds, g, S, E, F.wave);
                    VM_WAIT(); __builtin_amdgcn_fence(__ATOMIC_ACQUIRE, "agent"); VM_WAIT(); __syncthreads(); } });
        PHASE(if (EN(10)) { pg8::Gemm g{(const bf16*)(P.ws + WS_U8), (const bf16*)(P.ws + WS_WO), MROWS, DM, DM / 2, DM / 2, DM / 2}; pg8::StaticOrder S; S.init(MROWS, DM, F.G, F.bx, last);
                EpiOut E{P.out, (float*)(P.ws + WS_HC), (const float*)(P.ws + WS_MOD) + (size_t)l * 3 * 6144, 1.f / 32.f}; pg8::gemm_phase<EpiOut, pg8::StaticOrder, true>(F.lds, g, S, E, F.wave); });
        PHASE(if (EN(11)) ph_ln1(P, F, l, last));
        PHASE(if (EN(12)) { pg8::Gemm g{(const bf16*)(P.ws + WS_XQ), (const bf16*)(P.ws + WS_WQ8), MROWS, PQC, DM / 2, DM / 2, DM / 2}; pg8::StaticOrder S; S.init(MROWS, PQC, F.G, F.bx, last);
                EpiQ8 E{BIG, PQC, (const float*)(P.ws + WS_SX), (const float*)(P.ws + WS_SWQ)}; pg8::gemm_phase<EpiQ8, pg8::StaticOrder, false, true>(F.lds, g, S, E, F.wave); });
        PHASE(if (EN(13)) ph_topk(P, F, last));
        PHASE(if (EN(14)) ph_peer_u(P, F, last));
        PHASE(if (EN(14)) ph_peer_v(P, F, l, last));
    }
#undef PHASE
}

extern "C" void kernel_launch(void* const* d_in, const int* in_sizes, int n_in, void* d_out, int out_size, void* d_ws, size_t ws_size, hipStream_t stream) {
    static int grid = 0;
    if (grid == 0) {
        if (n_in != 21 || out_size != NB * SEQ * DM || ws_size < WS_END) { fprintf(stderr, "kernel_launch: unexpected shapes (n_in %d out %d ws %zu)\n", n_in, out_size, ws_size); grid = -1; return; }
        int dev = 0, cus = 0, per_cu = 0;
        if (hipGetDevice(&dev) != hipSuccess || hipDeviceGetAttribute(&cus, hipDeviceAttributeMultiprocessorCount, dev) != hipSuccess) { grid = -1; return; }
        if (hipFuncSetAttribute((const void*)hybrid_fwd, hipFuncAttributeMaxDynamicSharedMemorySize, LDS_BYTES) != hipSuccess) { fprintf(stderr, "kernel_launch: hipFuncSetAttribute failed\n"); grid = -1; return; }
        if (hipOccupancyMaxActiveBlocksPerMultiprocessor(&per_cu, (const void*)hybrid_fwd, NTHR, LDS_BYTES) != hipSuccess || per_cu < 1) { fprintf(stderr, "kernel_launch: occupancy query says %d\n", per_cu); }
        (void)hipGetLastError();
        grid = cus;
    }
    if (grid < 0) return;
    (void)hipMemsetAsync((char*)d_ws + WS_CTL, 0, CTL_ZERO_BYTES, stream);
    KArgs a{};
    for (int i = 0; i < 21; ++i) a.P.in[i] = (const float*)d_in[i];
    a.P.out = (float*)d_out; a.P.ws = (unsigned char*)d_ws;
#if MK_SPLIT
    for (int p = 0; p < NPHASE; ++p) { a.ph_lo = p; a.ph_hi = p + 1; hipLaunchKernelGGL(hybrid_fwd, dim3(grid), dim3(NTHR), LDS_BYTES, stream, a); }
#else
    a.ph_lo = 0; a.ph_hi = NPHASE;
    hipLaunchKernelGGL(hybrid_fwd, dim3(grid), dim3(NTHR), LDS_BYTES, stream, a);
#endif
}
```

```cpp
#include <hip/hip_runtime.h>
#include <cstdio>
#include <cstdint>

#define GAS __attribute__((address_space(1)))
#define LAS __attribute__((address_space(3)))
typedef unsigned short bf16;
typedef unsigned v4u __attribute__((ext_vector_type(4)));
typedef unsigned v2u __attribute__((ext_vector_type(2)));
typedef float f32x4 __attribute__((ext_vector_type(4)));
typedef float f32x2 __attribute__((ext_vector_type(2)));
typedef float f32x16 __attribute__((ext_vector_type(16)));
typedef short bf16x8 __attribute__((ext_vector_type(8)));
typedef short s16x4 __attribute__((ext_vector_type(4)));

__device__ __forceinline__ unsigned f2bf(float f) { unsigned u = __builtin_bit_cast(unsigned, f); return (u + 0x7fffu + ((u >> 16) & 1u)) >> 16; }
__device__ __forceinline__ unsigned pk2(float lo, float hi) { return f2bf(lo) | (f2bf(hi) << 16); }
__device__ __forceinline__ float bflo(unsigned w) { return __builtin_bit_cast(float, w << 16); }
__device__ __forceinline__ float bfhi(unsigned w) { return __builtin_bit_cast(float, w & 0xffff0000u); }
__device__ __forceinline__ float bf1(bf16 h) { return __builtin_bit_cast(float, ((unsigned)h) << 16); }
__device__ __forceinline__ float ex2(float x) { return __builtin_amdgcn_exp2f(x); }
__device__ __forceinline__ float sigmoidf_(float x) { return __builtin_amdgcn_rcpf(1.f + ex2(-1.4426950408889634f * x)); }
__device__ __forceinline__ int lane_id() { int r; asm volatile("v_mbcnt_lo_u32_b32 %0, -1, 0\n\tv_mbcnt_hi_u32_b32 %0, -1, %0" : "=v"(r)); return r; }
template <int M> __device__ __forceinline__ int lane_xor(int v) {
    if constexpr (M == 1) return __builtin_amdgcn_update_dpp(v, v, 0xB1, 0xf, 0xf, true);
    else if constexpr (M == 2) return __builtin_amdgcn_update_dpp(v, v, 0x4E, 0xf, 0xf, true);
    else if constexpr (M == 4) { const int a = __builtin_amdgcn_update_dpp(v, v, 0x104, 0xf, 0x5, false); return __builtin_amdgcn_update_dpp(a, v, 0x114, 0xf, 0xA, false); }
    else if constexpr (M == 8) return __builtin_amdgcn_update_dpp(v, v, 0x128, 0xf, 0xf, true);
    else if constexpr (M == 16) { auto rr = __builtin_amdgcn_permlane16_swap((unsigned)v, (unsigned)v, false, false); return __builtin_amdgcn_update_dpp((int)rr[1], (int)rr[0], 0xE4, 0xA, 0xf, false); }
    else { static_assert(M == 32, "lane_xor"); auto rr = __builtin_amdgcn_permlane32_swap((unsigned)v, (unsigned)v, false, false); return __builtin_amdgcn_update_dpp((int)rr[1], (int)rr[0], 0xE4, 0xC, 0xf, false); }
}
template <int M> __device__ __forceinline__ float lane_xor(float v) { return __builtin_bit_cast(float, lane_xor<M>(__builtin_bit_cast(int, v))); }
__device__ __forceinline__ float wave_sum(float v) {
    v += lane_xor<1>(v); v += lane_xor<2>(v); v += lane_xor<4>(v); v += lane_xor<8>(v); v += lane_xor<16>(v); v += lane_xor<32>(v);
    return v;
}
__device__ __forceinline__ float wave_max(float v) {
    v = fmaxf(v, lane_xor<1>(v)); v = fmaxf(v, lane_xor<2>(v)); v = fmaxf(v, lane_xor<4>(v)); v = fmaxf(v, lane_xor<8>(v)); v = fmaxf(v, lane_xor<16>(v)); v = fmaxf(v, lane_xor<32>(v));
    return v;
}
__device__ __forceinline__ int opqs(int x) { asm volatile("" : "+s"(x)); return x; }
__device__ __forceinline__ int opq(int x) { asm volatile("" : "+v"(x)); return x; }
__device__ __forceinline__ f32x16 zero16() {
    float z[16];
#pragma unroll
    for (int i = 0; i < 16; i += 4) asm volatile("v_mov_b32 %0, 0\n\tv_mov_b32 %1, 0\n\tv_mov_b32 %2, 0\n\tv_mov_b32 %3, 0" : "=v"(z[i]), "=v"(z[i + 1]), "=v"(z[i + 2]), "=v"(z[i + 3]));
    return (f32x16){z[0], z[1], z[2], z[3], z[4], z[5], z[6], z[7], z[8], z[9], z[10], z[11], z[12], z[13], z[14], z[15]};
}
#define LDS_WAIT() asm volatile("s_waitcnt lgkmcnt(0)" ::: "memory")
#define VM_WAIT() asm volatile("s_waitcnt vmcnt(0)" ::: "memory")

namespace pg8 {
#define PG8_LAS __attribute__((address_space(3)))
typedef unsigned short bf16_t;
typedef short bf16x8 __attribute__((ext_vector_type(8)));
typedef float f32x4 __attribute__((ext_vector_type(4)));
typedef unsigned u32x4 __attribute__((ext_vector_type(4)));
constexpr int BM = 256, BK = 64, HALF = 128, HTB = HALF * BK * 2, STAGE_BYTES = 8 * HTB, NXCD = 8, WGM = 8;
__host__ __device__ __forceinline__ int lds_byte(int r, int c) { const int st = (r >> 4) * 2 + (c >> 5), rr = r & 15, cc = c & 31, ob = rr * 64 + cc * 2; return st * 1024 + (ob ^ (((ob >> 9) & 1) << 5)); }
__host__ __device__ __forceinline__ void stage_rc(int b, int& R, int& C) { const int st = b / 1024, sb = b % 1024, swz = sb ^ (((sb >> 9) & 1) << 5); R = (st >> 1) * 16 + swz / 64; C = (st & 1) * 32 + (swz % 64) / 2; }
__host__ __device__ __forceinline__ int perm32(int rho) { const int n = rho >> 4, i = rho & 15; return 8 * (i >> 2) + 4 * n + (i & 3); }
struct Unit { int pm, pn; };
struct Gemm { const bf16_t* A; const bf16_t* Bt; int M, N, K, lda, ldb; };
struct StaticOrder {
    int nM, nN, nwg, G, c, skip;
    __host__ __device__ void init(int M, int N, int G_, int c_, int skip_ = 0) { skip = skip_; nM = skip_ ? 128 : M / BM; nN = N / BM; nwg = nM * nN; G = G_; c = c_; }
    __host__ __device__ bool next(int i, Unit& u) const {
        const long L = (long)i * G + c; if (L >= nwg) return false;
        int wgid = (int)L; { const int q = nwg / NXCD, r = nwg % NXCD, xcd = wgid % NXCD, off = wgid / NXCD; wgid = (xcd < r ? xcd * (q + 1) : r * (q + 1) + (xcd - r) * q) + off; }
        const int nig = WGM * nN, gid = wgid / nig, fm = gid * WGM, gsz = (nM - fm) < WGM ? (nM - fm) : WGM;
        u.pm = fm + ((wgid % nig) % gsz); u.pn = (wgid % nig) / gsz; if (skip) u.pm += 1 + (u.pm >= 64 ? 1 : 0); return true;
    }
};
__device__ __forceinline__ unsigned cvt_pk_bf16(float lo, float hi) { unsigned r; asm volatile("v_cvt_pk_bf16_f32 %0, %1, %2" : "=v"(r) : "v"(lo), "v"(hi)); return r; }

template <class Epi, class Sched, bool FP8 = false, bool I8 = false>
__device__ __forceinline__ void gemm_phase(PG8_LAS unsigned char* lds, const Gemm g, const Sched& S, const Epi& E, int wid) {
    const int lane = opq(lane_id()), tid = wid * 64 + lane, wr = wid >> 2, wc = wid & 3, fr = lane & 15, fq = lane >> 4;
    const int K = g.K, nt = K / BK;
    unsigned voffA[2], voffB[2];
#pragma unroll
    for (int i = 0; i < 2; ++i) { int R, C; stage_rc(tid * 16 + i * 8192, R, C); const int Rb = Epi::PERM ? ((R & ~31) + perm32(R & 31)) : R;
        voffA[i] = (unsigned)(R * g.lda + C) * 2u; voffB[i] = (unsigned)(Rb * g.ldb + C) * 2u; }
    const size_t kstep = (size_t)(BK * 2);
    const size_t hstepA = (size_t)HALF * g.lda * 2, hstepB = (size_t)HALF * g.ldb * 2;
    const size_t tstepA = 2 * hstepA, tstepB = 2 * hstepB;
    const unsigned ldsw = (unsigned)wid * 1024u;
    const int aoff = lds_byte(wr * 64 + fr, fq * 8), boff = lds_byte(wc * 32 + fr, fq * 8);
#define PG8_SA(b, h) (((b) * 2 + (h)) * HTB)
#define PG8_SB(b, h) ((4 + (b) * 2 + (h)) * HTB)
#define PG8_STAGE(bufoff, gbase, voff) do { _Pragma("unroll") for (int _i = 0; _i < 2; ++_i) { \
        if constexpr (FP8 || I8) {   \
            unsigned keep_; const char* gb_ = (const char*)(gbase); const unsigned la_ = (unsigned)(uintptr_t)(lds + (bufoff) + ldsw + _i * 8192); \
            asm volatile("s_mov_b32 %0, m0\n\ts_mov_b32 m0, %3\n\ts_nop 0\n\tglobal_load_lds_dwordx4 %1, %2\n\ts_mov_b32 m0, %0" : "=&s"(keep_) : "v"((voff)[_i]), "s"(gb_), "s"(la_) : "memory"); } \
        else __builtin_amdgcn_global_load_lds((const unsigned*)((const char*)(gbase) + (voff)[_i]), (PG8_LAS unsigned*)(lds + (bufoff) + ldsw + _i * 8192), 16, 0, 0); } } while (0)
#define PG8_LDA(dst, b, h) do { _Pragma("unroll") for (int m = 0; m < 4; ++m) { const bf16x8 f0_ = *(const PG8_LAS bf16x8*)(lds + PG8_SA(b, h) + aoff + m * 2048), f1_ = *(const PG8_LAS bf16x8*)(lds + PG8_SA(b, h) + aoff + m * 2048 + 1024); \
        dst[m] = __builtin_shufflevector(__builtin_bit_cast(v4i_, f0_), __builtin_bit_cast(v4i_, f1_), 0, 1, 2, 3, 4, 5, 6, 7); } } while (0)
#define PG8_LDB(dst, b, h) do { _Pragma("unroll") for (int n = 0; n < 2; ++n) { const bf16x8 f0_ = *(const PG8_LAS bf16x8*)(lds + PG8_SB(b, h) + boff + n * 2048), f1_ = *(const PG8_LAS bf16x8*)(lds + PG8_SB(b, h) + boff + n * 2048 + 1024); \
        dst[n] = __builtin_shufflevector(__builtin_bit_cast(v4i_, f0_), __builtin_bit_cast(v4i_, f1_), 0, 1, 2, 3, 4, 5, 6, 7); } } while (0)
#define PG8_MMA(ai, bj, At, Bt) do { __builtin_amdgcn_s_setprio(1); _Pragma("unroll") for (int m = 0; m < 4; ++m) _Pragma("unroll") for (int n = 0; n < 2; ++n) { \
        if constexpr (FP8) acc[ai][bj][m][n] = __builtin_amdgcn_mfma_scale_f32_16x16x128_f8f6f4(Bt[n], At[m], acc[ai][bj][m][n], 0, 0, 0, 0, 0, 0); \
        else if constexpr (I8) { v4i_ c_ = __builtin_bit_cast(v4i_, acc[ai][bj][m][n]);   \
               c_ = __builtin_amdgcn_mfma_i32_16x16x64_i8(__builtin_shufflevector(Bt[n], Bt[n], 0, 1, 2, 3), __builtin_shufflevector(At[m], At[m], 0, 1, 2, 3), c_, 0, 0, 0); \
               c_ = __builtin_amdgcn_mfma_i32_16x16x64_i8(__builtin_shufflevector(Bt[n], Bt[n], 4, 5, 6, 7), __builtin_shufflevector(At[m], At[m], 4, 5, 6, 7), c_, 0, 0, 0); \
               acc[ai][bj][m][n] = __builtin_bit_cast(f32x4, c_); } \
        else { acc[ai][bj][m][n] = __builtin_amdgcn_mfma_f32_16x16x32_bf16(__builtin_bit_cast(bf16x8, __builtin_shufflevector(Bt[n], Bt[n], 0, 1, 2, 3)), __builtin_bit_cast(bf16x8, __builtin_shufflevector(At[m], At[m], 0, 1, 2, 3)), acc[ai][bj][m][n], 0, 0, 0); \
               acc[ai][bj][m][n] = __builtin_amdgcn_mfma_f32_16x16x32_bf16(__builtin_bit_cast(bf16x8, __builtin_shufflevector(Bt[n], Bt[n], 4, 5, 6, 7)), __builtin_bit_cast(bf16x8, __builtin_shufflevector(At[m], At[m], 4, 5, 6, 7)), acc[ai][bj][m][n], 0, 0, 0); } } \
        __builtin_amdgcn_s_setprio(0); } while (0)
#define PG8_WAIT_V(n) asm volatile("s_waitcnt vmcnt(" #n ")" ::: "memory")
#define PG8_WAIT_L(n) asm volatile("s_waitcnt lgkmcnt(" #n ")" ::: "memory")
#define PG8_BAR __builtin_amdgcn_s_barrier()
#define PG8_SCHED __builtin_amdgcn_sched_barrier(0)
    Unit cur, nxt; int ui = 0;
    if (!S.next(0, cur)) return;
    f32x4 acc[2][2][4][2];
#define PG8_ZERO_ACC() do { _Pragma("unroll") for (int a = 0; a < 2; ++a) _Pragma("unroll") for (int b = 0; b < 2; ++b) _Pragma("unroll") for (int m = 0; m < 4; ++m) _Pragma("unroll") for (int n = 0; n < 2; ++n) { \
        float z0, z1, z2, z3; asm volatile("v_mov_b32 %0, 0\n\tv_mov_b32 %1, 0\n\tv_mov_b32 %2, 0\n\tv_mov_b32 %3, 0" : "=v"(z0), "=v"(z1), "=v"(z2), "=v"(z3)); acc[a][b][m][n] = (f32x4){z0, z1, z2, z3}; } } while (0)
    PG8_ZERO_ACC();
    typedef int v4i_ __attribute__((ext_vector_type(4))); typedef int v8i_ __attribute__((ext_vector_type(8)));
    v8i_ At[4], B0[2], B1[2];
    const char* cA = (const char*)g.A + (size_t)cur.pm * tstepA; const char* cB = (const char*)g.Bt + (size_t)cur.pn * tstepB;
    PG8_STAGE(PG8_SB(0, 0), cB, voffB); PG8_STAGE(PG8_SB(0, 1), cB + hstepB, voffB); PG8_STAGE(PG8_SA(0, 0), cA, voffA); PG8_STAGE(PG8_SA(0, 1), cA + hstepA, voffA);
    if (wr == 1) PG8_BAR;
    PG8_WAIT_V(2); PG8_BAR;
    PG8_STAGE(PG8_SB(1, 0), cB + kstep, voffB); PG8_STAGE(PG8_SA(1, 0), cA + kstep, voffA); PG8_STAGE(PG8_SB(1, 1), cB + hstepB + kstep, voffB);
    PG8_WAIT_V(6); PG8_BAR;
    for (;;) {
        const bool has_next = S.next(ui + 1, nxt);
        const char* nA = has_next ? (const char*)g.A + (size_t)nxt.pm * tstepA : cA; const char* nB = has_next ? (const char*)g.Bt + (size_t)nxt.pn * tstepB : cB;
#pragma unroll 1
        for (int t = 0; t < nt; t += 2) {
            const bool last = (t == nt - 2);
            const char* a1 = cA + (size_t)(t + 1) * kstep;
            const char* a2 = last ? nA : cA + (size_t)(t + 2) * kstep; const char* b2 = last ? nB : cB + (size_t)(t + 2) * kstep;
            const char* a3 = a2 + kstep; const char* b3 = b2 + kstep;
            PG8_LDB(B0, 0, 0); PG8_LDB(B1, 0, 1); PG8_SCHED; PG8_LDA(At, 0, 0); PG8_STAGE(PG8_SA(1, 1), a1 + hstepA, voffA);
            PG8_WAIT_V(8); PG8_WAIT_L(0); PG8_BAR; PG8_MMA(0, 0, At, B0); PG8_MMA(0, 1, At, B1); PG8_BAR; PG8_SCHED;
            PG8_LDA(At, 0, 1); PG8_STAGE(PG8_SB(0, 0), b2, voffB); PG8_STAGE(PG8_SB(0, 1), b2 + hstepB, voffB); PG8_STAGE(PG8_SA(0, 0), a2, voffA);
            PG8_WAIT_V(8); PG8_WAIT_L(0); PG8_BAR; PG8_MMA(1, 0, At, B0); PG8_MMA(1, 1, At, B1); PG8_BAR; PG8_SCHED;
            PG8_LDB(B0, 1, 0); PG8_LDB(B1, 1, 1); PG8_SCHED; PG8_LDA(At, 1, 0); PG8_STAGE(PG8_SA(0, 1), a2 + hstepA, voffA);
            PG8_WAIT_V(8); PG8_WAIT_L(0); PG8_BAR; PG8_MMA(0, 0, At, B0); PG8_MMA(0, 1, At, B1); PG8_BAR; PG8_SCHED;
            PG8_LDA(At, 1, 1); PG8_STAGE(PG8_SB(1, 0), b3, voffB); PG8_STAGE(PG8_SB(1, 1), b3 + hstepB, voffB); PG8_STAGE(PG8_SA(1, 0), a3, voffA);
            PG8_WAIT_V(8); PG8_WAIT_L(0); PG8_BAR; PG8_MMA(1, 0, At, B0); PG8_MMA(1, 1, At, B1); PG8_BAR; PG8_SCHED;
        }
        if (wr == 0) PG8_BAR;
        E(acc, cur, wr, wc, fr, fq);
        if (!has_next) break;
        PG8_ZERO_ACC();
        cur = nxt; cA = nA; cB = nB; ++ui;
        if (wr == 1) PG8_BAR;
    }
    PG8_WAIT_V(0);
    PG8_BAR;
#undef PG8_ZERO_ACC
#undef PG8_SA
#undef PG8_SB
#undef PG8_STAGE
#undef PG8_LDA
#undef PG8_LDB
#undef PG8_MMA
#undef PG8_WAIT_V
#undef PG8_WAIT_L
#undef PG8_BAR
#undef PG8_SCHED
}
}
#define XB_TMO      128
#define XB_XCNT(j)  (256  + 64 * (j))
#define XB_XSUB(j)  (1280 + 64 * (j))
#define XB_XGEN(j)  (2304 + 64 * (j))
#define XB_TOP      3328
#define XB_TOPGEN   3392
#define XCD_BAR_WORDS 3456
#define XB_SPIN_CAP (1u << 18)
__device__ __forceinline__ unsigned xb_ld(unsigned* p)              { return __hip_atomic_load(p, __ATOMIC_RELAXED, __HIP_MEMORY_SCOPE_AGENT); }
__device__ __forceinline__ unsigned xb_add(unsigned* p, unsigned v) { return __hip_atomic_fetch_add(p, v, __ATOMIC_RELAXED, __HIP_MEMORY_SCOPE_AGENT); }
__device__ __forceinline__ unsigned xb_xcc_id() { return (unsigned)__builtin_amdgcn_s_getreg((3 << 11) | 20) & 0xFu; }
#define XB_SPIN(cond, bar) do { unsigned _sp = 0; while (cond) { __builtin_amdgcn_s_sleep(1); \
    if ((++_sp & 255u) == 0u) { if (xb_ld(&(bar)[XB_TMO])) break; if (_sp > XB_SPIN_CAP) { atomicAdd(&(bar)[XB_TMO], 1u); break; } } } } while (0)
struct XcdBarrier { unsigned* bar; unsigned x; volatile LAS unsigned* st; unsigned w0; };
__device__ __forceinline__ XcdBarrier xcd_barrier_post(unsigned* bar, volatile LAS unsigned* st) {
    XcdBarrier b; b.bar = bar; b.x = xb_xcc_id(); b.st = st; b.w0 = 0u;
    if (threadIdx.x == 0) (void)xb_add(&bar[XB_XCNT(b.x)], 1u);
    return b;
}
__device__ __forceinline__ void xcd_barrier_complete(unsigned* bar, unsigned x, unsigned& nloc, unsigned& nx) {
    const unsigned G = gridDim.x * gridDim.y * gridDim.z;
    unsigned sum, cnt, mine, sp = 0u;
    for (;;) {
        sum = 0u; cnt = 0u; mine = 0u;
#pragma unroll
        for (unsigned j = 0; j < 16; ++j) { const unsigned c = xb_ld(&bar[XB_XCNT(j)]); sum += c; cnt += (c > 0u) ? 1u : 0u; mine = (j == x) ? c : mine; }
        if (sum == G) break;
        __builtin_amdgcn_s_sleep(1);
        if ((++sp & 255u) == 0u) { if (xb_ld(&bar[XB_TMO])) break; if (sp > XB_SPIN_CAP) { atomicAdd(&bar[XB_TMO], 1u); break; } }
    }
    nloc = mine > 0u ? mine : 1u; nx = cnt > 0u ? cnt : 1u;
}
__device__ __forceinline__ void xcd_barrier(const XcdBarrier& b) {
    asm volatile("s_waitcnt vmcnt(0)" ::: "memory");
    __syncthreads();
    if (b.w0 && lane_id() == 0) {
        unsigned* bar = b.bar; asm volatile("" : "+s"(bar));
        __builtin_amdgcn_s_waitcnt(0);
        unsigned nloc = b.st[0], nx = b.st[1];
        if (nloc == 0u) { xcd_barrier_complete(bar, b.x, nloc, nx); b.st[0] = nloc; b.st[1] = nx; }
        const unsigned old = xb_add(&bar[XB_XSUB(b.x)], 1u);
        const unsigned gen = old / nloc;
        if (old + 1u == (gen + 1u) * nloc) {
            __builtin_amdgcn_fence(__ATOMIC_RELEASE, "agent");
            asm volatile("s_waitcnt vmcnt(0)" ::: "memory");
            const unsigned og = xb_add(&bar[XB_TOP], 1u);
            const unsigned tg = og / nx;
            if (og + 1u == (tg + 1u) * nx) xb_add(&bar[XB_TOPGEN], 1u);
            else XB_SPIN(xb_ld(&bar[XB_TOPGEN]) == tg, bar);
            __builtin_amdgcn_fence(__ATOMIC_ACQUIRE, "agent");
            xb_add(&bar[XB_XGEN(b.x)], 1u);
            asm volatile("s_waitcnt vmcnt(0)" ::: "memory");
        } else {
            XB_SPIN(xb_ld(&bar[XB_XGEN(b.x)]) == gen, bar);
            __builtin_amdgcn_fence(__ATOMIC_ACQUIRE, "agent");
            asm volatile("s_waitcnt vmcnt(0)" ::: "memory");
        }
    }
    __syncthreads();
}

namespace attn_body {
using u32x4=__attribute__((ext_vector_type(4)))unsigned;
constexpr int NW=8,QBLK=32,QB=QBLK*NW,KVBLK=64,QK8P=384,VTP=16640;
__device__ __forceinline__ int crow(int r,int hi){return (r&3)+8*(r>>2)+4*hi;}
#define SBAR() __builtin_amdgcn_sched_barrier(0)
constexpr int NSLOT=3, SLOTB=8192;
constexpr int LDS_K=0, LDS_V=NSLOT*SLOTB, LDS_WS=2*NSLOT*SLOTB, LDS_OST=LDS_WS+NW*64*4, LDS_BYTES=LDS_OST+2*NW*4096;
__device__ __forceinline__ void glds16(const void*gsrc,unsigned lds_dst){unsigned keep;
  asm volatile("s_mov_b32 %0, m0\n\ts_mov_b32 m0, %2\n\ts_nop 0\n\tglobal_load_lds_dwordx4 %1, off\n\ts_mov_b32 m0, %0":"=&s"(keep):"v"(gsrc),"s"(lds_dst):"memory");}
__device__ __forceinline__ float max3f(float a,float b,float c){float r;asm("v_max3_f32 %0, %1, %2, %3":"=v"(r):"v"(a),"v"(b),"v"(c));return r;}
__device__ __forceinline__ float max2f(float a,float b){float r;asm("v_max_f32_e32 %0, %1, %2":"=v"(r):"v"(a),"v"(b));return r;}
__device__ __forceinline__ float fadd_s(float a,float b){float r;asm("v_add_f32_e32 %0, %1, %2":"=v"(r):"v"(a),"v"(b));return r;}
__device__ __forceinline__ float fsub_s(float a,float b){float r;asm("v_sub_f32_e32 %0, %1, %2":"=v"(r):"v"(a),"v"(b));return r;}
typedef float f32x2_t __attribute__((ext_vector_type(2))); typedef __bf16 bf16x2_t __attribute__((ext_vector_type(2)));
__device__ __forceinline__ unsigned cvtpk_s(float lo,float hi){f32x2_t v={lo,hi};bf16x2_t b=__builtin_convertvector(v,bf16x2_t);return __builtin_bit_cast(unsigned,b);}
#define WAIT_BAR(N) asm volatile("s_waitcnt vmcnt(" #N ") lgkmcnt(0)\n\ts_barrier":::"memory")

typedef __attribute__((address_space(3))) const char* lds_cptr;
template<int ND0=4> __device__ __forceinline__ void qkt(f32x16&p0,f32x16&p1,lds_cptr Kslot,const bf16x8*qr,const f32x16&negm,int r32,int hi){
  const lds_cptr kb=Kslot+hi*1024+r32*16;
  #pragma unroll
  for(int d0=0;d0<ND0;++d0){
    const bf16x8 b0=*(const __attribute__((address_space(3))) bf16x8*)(kb+d0*2048);
    const bf16x8 b1=*(const __attribute__((address_space(3))) bf16x8*)(kb+d0*2048+512);
    if(d0==0){p0=__builtin_amdgcn_mfma_f32_32x32x16_bf16(b0,qr[0],negm,0,0,0);p1=__builtin_amdgcn_mfma_f32_32x32x16_bf16(b1,qr[0],negm,0,0,0);}
    else{p0=__builtin_amdgcn_mfma_f32_32x32x16_bf16(b0,qr[d0],p0,0,0,0);p1=__builtin_amdgcn_mfma_f32_32x32x16_bf16(b1,qr[d0],p1,0,0,0);}}
}
typedef int v8i_t __attribute__((ext_vector_type(8))); typedef int v4i_t __attribute__((ext_vector_type(4)));
__device__ __forceinline__ v8i_t kload8q(lds_cptr kp){ const v4i_t a=*(const __attribute__((address_space(3))) v4i_t*)(kp), c=*(const __attribute__((address_space(3))) v4i_t*)(kp+1024); return __builtin_shufflevector(a,c,0,1,2,3,4,5,6,7); }
__device__ __forceinline__ void qkt8(f32x16&p0,f32x16&p1,lds_cptr Kslot,const v8i_t qr8,const f32x16&negm,int r32,int hi){
  const lds_cptr kb=Kslot+hi*2048+r32*16;
  p0=__builtin_amdgcn_mfma_scale_f32_32x32x64_f8f6f4(kload8q(kb),qr8,negm,0,0,0,0,0,0);
  p1=__builtin_amdgcn_mfma_scale_f32_32x32x64_f8f6f4(kload8q(kb+512),qr8,negm,0,0,0,0,0,0);
}
typedef short v4i16_t __attribute__((ext_vector_type(4)));
__device__ __forceinline__ void kload8(bf16x8*kf,lds_cptr kp){
  kf[0]=*(const __attribute__((address_space(3))) bf16x8*)(kp);      kf[1]=*(const __attribute__((address_space(3))) bf16x8*)(kp+512);
  kf[2]=*(const __attribute__((address_space(3))) bf16x8*)(kp+2048); kf[3]=*(const __attribute__((address_space(3))) bf16x8*)(kp+2560);
  kf[4]=*(const __attribute__((address_space(3))) bf16x8*)(kp+4096); kf[5]=*(const __attribute__((address_space(3))) bf16x8*)(kp+4608);
  kf[6]=*(const __attribute__((address_space(3))) bf16x8*)(kp+6144); kf[7]=*(const __attribute__((address_space(3))) bf16x8*)(kp+6656);
}
__device__ __forceinline__ void kload2(bf16x8*kf,lds_cptr kp,int j){ kf[2*j]=*(const __attribute__((address_space(3))) bf16x8*)(kp+j*2048); kf[2*j+1]=*(const __attribute__((address_space(3))) bf16x8*)(kp+j*2048+512); }
__device__ __forceinline__ s16x4 vtr(lds_cptr p){ return __builtin_bit_cast(s16x4,__builtin_amdgcn_ds_read_tr16_b64_v4i16((__attribute__((address_space(3))) v4i16_t*)p)); }
__device__ __forceinline__ float rowmax(const f32x16&p0,const f32x16&p1){
  float a=max3f(p0[0],p0[1],p1[0]),b=max3f(p0[2],p0[3],p1[1]);a=max3f(a,p1[2],p1[3]);
  #pragma unroll
  for(int r=4;r<16;r+=4){a=max3f(a,p0[r],p0[r+1]);b=max3f(b,p0[r+2],p0[r+3]);a=max3f(a,p1[r],p1[r+1]);b=max3f(b,p1[r+2],p1[r+3]);}
  const float m=max2f(a,b);
  auto rr=__builtin_amdgcn_permlane32_swap(__float_as_uint(m),__float_as_uint(m),false,false);
  return max2f(__uint_as_float(rr[0]),__uint_as_float(rr[1]));
}
__device__ __forceinline__ void pv(f32x16*o,int vb,bf16x8 pa0,bf16x8 pa1,bf16x8 pa2,bf16x8 pa3){
  #pragma unroll
  for(int d0=0;d0<2;++d0){s16x4 lo[4],hi[4];
    #pragma unroll
    for(int ks=0;ks<4;++ks){
      asm volatile("ds_read_b64_tr_b16 %0,%1 offset:%c2":"=&v"(lo[ks]):"v"(vb),"i"(d0*4096+ks*1024):"memory");
      asm volatile("ds_read_b64_tr_b16 %0,%1 offset:%c2":"=&v"(hi[ks]):"v"(vb),"i"(d0*4096+ks*1024+512):"memory");}
    asm volatile("s_waitcnt lgkmcnt(0)":::"memory");SBAR();
    #define PK(k) (bf16x8){lo[k][0],lo[k][1],lo[k][2],lo[k][3],hi[k][0],hi[k][1],hi[k][2],hi[k][3]}
    o[d0]=__builtin_amdgcn_mfma_f32_32x32x16_bf16(pa0,PK(0),o[d0],0,0,0);
    o[d0]=__builtin_amdgcn_mfma_f32_32x32x16_bf16(pa1,PK(1),o[d0],0,0,0);
    o[d0]=__builtin_amdgcn_mfma_f32_32x32x16_bf16(pa2,PK(2),o[d0],0,0,0);
    o[d0]=__builtin_amdgcn_mfma_f32_32x32x16_bf16(pa3,PK(3),o[d0],0,0,0);
    #undef PK
  }
}
__device__ __forceinline__ void wmask(f32x16&p0,f32x16&p1,int ts,int qlat,int hi){
  if(ts>=4){ const float NEG=-INFINITY; const int kb=64*(ts-4)+4*hi-qlat;
    #pragma unroll
    for(int r=0;r<16;++r){const int d=kb+(r&3)+8*(r>>2); if(d>128||d<-128)p0[r]=NEG; if(d+32>128||d+32<-128)p1[r]=NEG;} }
}

template<int THRL,bool D32,bool WIN,bool Q8=false> __device__ __forceinline__ void attn_core(const bf16*Qu,int qpitch,const bf16*__restrict__ Kh,const bf16*__restrict__ Vh,int kvp,int NT,int woff,int q0lat,int win,float kmax,float sk2,int ost,char*shm,int wid,const unsigned char*Q8u=nullptr,const unsigned char*K8h=nullptr,const unsigned char*V8Th=nullptr,int q8p=QK8P,int qmask=-1){
  const int lane=opq(lane_id()),r32=lane&31,hi=lane>>5;
  if(wid>=4)__builtin_amdgcn_s_setprio(1);
  const bf16*Qw=Qu+(long)(wid*QBLK)*qpitch;
  const unsigned lds0=(unsigned)(uintptr_t)shm;
  float*wsf=(float*)(shm+LDS_WS)+wid*64;
  const char*ksrc=Q8?(const char*)K8h+(long)lane*q8p+wid*16:(const char*)(Kh+(long)lane*kvp+wid*8); const long kstp=Q8?(long)KVBLK*q8p:(long)KVBLK*kvp*2;
  const bf16*vsrc=Vh+(long)(16*(wid&3)+(lane>>2))*kvp+(wid>>2)*32+(lane&3)*8;
  const unsigned char*vsrc8=V8Th+(long)lane*VTP+((wid&3)*16);
  const unsigned kdst=lds0+LDS_K+wid*1024, vdst=lds0+LDS_V+wid*1024;
  #define TM(t) ((t)+(((t)>=4)?woff:0))
  const bool kdma=!(D32||Q8)||wid<4;
  #define DMA_K(t,slot) do{ if(kdma) glds16(ksrc+(long)TM(t)*kstp,(unsigned)__builtin_amdgcn_readfirstlane(kdst+(slot))); }while(0)
  #define DMA_V(t,slot) do{ if constexpr(Q8){ if(!kdma) glds16(vsrc8+(long)TM(t)*KVBLK,(unsigned)__builtin_amdgcn_readfirstlane(lds0+LDS_V+(wid&3)*1024+(slot))); } else glds16(vsrc+(long)TM(t)*KVBLK*kvp,(unsigned)__builtin_amdgcn_readfirstlane(vdst+(slot))); }while(0)
  const int vb0=(int)(lds0+LDS_V)+((lane>>4)&1)*32+(lane&3)*8+(4*hi+((lane&15)>>2))*64;
  bf16x8 kf[8]; v8i_t kf8[2]; v8i_t qr8;
  const lds_cptr shm3=(lds_cptr)shm; const lds_cptr kq0=shm3+LDS_K+hi*2048+r32*16; const lds_cptr vq0=shm3+LDS_V+hi*2048+r32*16; const lds_cptr kp0=shm3+LDS_K+hi*1024+r32*16; const lds_cptr vp0=shm3+LDS_V+((lane>>4)&1)*32+(lane&3)*8+(4*hi+((lane&15)>>2))*64;
  DMA_K(0,0);DMA_V(0,0);DMA_K(1,SLOTB);
  bf16x8 qr[4];
  if constexpr(Q8){ const unsigned char*qp=Q8u+(long)(wid*QBLK+r32)*q8p+32*hi; const v4i_t a=*(const v4i_t*)qp, c=*(const v4i_t*)(qp+16); qr8=__builtin_shufflevector(a,c,0,1,2,3,4,5,6,7);
    if(qmask>=0&&hi!=qmask)qr8=v8i_t{};
    qr[0]=bf16x8{};qr[1]=bf16x8{};qr[2]=bf16x8{};qr[3]=bf16x8{}; }
  else {
  #pragma unroll
  for(int d0=0;d0<(D32?2:4);++d0)qr[d0]=*reinterpret_cast<const bf16x8*>(&Qw[(long)r32*qpitch+d0*16+hi*8]);
  if constexpr(D32){qr[2]=bf16x8{};qr[3]=bf16x8{};} qr8=v8i_t{}; }
  float qn2=0.f;
  if constexpr(Q8){
    #pragma unroll
    for(int j=0;j<8;++j){ const f32x2_t lo=__builtin_amdgcn_cvt_pk_f32_fp8(qr8[j],false), hh=__builtin_amdgcn_cvt_pk_f32_fp8(qr8[j],true); qn2+=lo[0]*lo[0]+lo[1]*lo[1]+hh[0]*hh[0]+hh[1]*hh[1]; } }
  else
  #pragma unroll
  for(int d0=0;d0<(D32?2:4);++d0){ const u32x4 qq=__builtin_bit_cast(u32x4,qr[d0]);
    #pragma unroll
    for(int j=0;j<4;++j){ const float a=bflo(qq[j]),c=bfhi(qq[j]); qn2+=a*a+c*c; } }
  {auto rr=__builtin_amdgcn_permlane32_swap(__float_as_uint(qn2),__float_as_uint(qn2),false,false);qn2=__uint_as_float(rr[0])+__uint_as_float(rr[1]);}
  const float mhat=__builtin_sqrtf(qn2)*kmax*1.001f+0.05f;
  float l_reg=0.f;f32x16 o[2];o[0]=zero16();o[1]=zero16();f32x16 negm;
  #pragma unroll
  for(int r=0;r<16;++r)negm[r]=Q8?12.f-mhat:-mhat;
  asm volatile("":"+v"(negm));
  const int qlat=q0lat+wid*QBLK+r32;
  #define CMASK(P0,P1,t) do{ if constexpr(WIN){ wmask(P0,P1,TM(t),qlat,hi); } }while(0)
  f32x16 pA0,pA1,pB0,pB1;
  int sl_prev=0,sl_cur=0,sl_next=SLOTB;
  #define ROT() do{sl_prev=sl_cur;sl_cur=sl_next;sl_next=(sl_next==(NSLOT-1)*SLOTB)?0:sl_next+SLOTB;}while(0)
  DMA_K(2,2*SLOTB);
  if constexpr(Q8){WAIT_BAR(2);}else{WAIT_BAR(3);}
  if constexpr(Q8) qkt8(pA0,pA1,shm3+LDS_K,qr8,negm,r32,hi); else qkt<(D32?2:4)>(pA0,pA1,shm3+LDS_K,qr,negm,r32,hi);
  asm volatile("s_nop 15\n\ts_nop 7":"+v"(pA0),"+v"(pA1));CMASK(pA0,pA1,0);
  _Pragma("unroll") for(int r=0;r<16;++r){pA0[r]=__builtin_amdgcn_exp2f(pA0[r]);pA1[r]=__builtin_amdgcn_exp2f(pA1[r]);}
  WAIT_BAR(0);
  DMA_K(3,0);DMA_V(1,SLOTB);
  ROT();
  if constexpr(Q8){kf8[0]=kload8q(kq0+sl_cur);kf8[1]=kload8q(kq0+sl_cur+512);} else if constexpr(D32){kload2(kf,kp0+sl_cur,0);kload2(kf,kp0+sl_cur,1);} else kload8(kf,kp0+sl_cur);
  WAIT_BAR(2);
  s16x4 vlo[8],vhi[8]; u32x4 pw0,pw1,pw2,pw3;
  #define PKW(P,B) cvtpk_s(P[B],P[B+1])
  #define PAF(k) __builtin_bit_cast(bf16x8,pw##k)
  #define VFR(i) (bf16x8){vlo[i][0],vlo[i][1],vlo[i][2],vlo[i][3],vhi[i][0],vhi[i][1],vhi[i][2],vhi[i][3]}
  #define PIN(x) asm volatile("":"+v"(x))
  #define MX3(a,b,c) __builtin_fmaxf(__builtin_fmaxf((a),(b)),(c))
  #define GAPA(MF,A0,A1,A2,A3,W0,W1,PW) do{ MF; sacc+=A0; sacc+=A1; sacc+=A2; sacc+=A3; PIN(sacc); W0; W1; PIN(PW); SBAR(); }while(0)
  #define EX(v) __builtin_amdgcn_exp2f(v)
  #define GAPB(MF,X,B) do{ MF; X[B]=EX(X[B]); X[B+1]=EX(X[B+1]); X[B+2]=EX(X[B+2]); X[B+3]=EX(X[B+3]); PIN(X); SBAR(); }while(0)
  #define VRD(i) do{ vlo[i]=vtr(vp_+(((i)>>2)*4096+((i)&3)*1024)); vhi[i]=vtr(vp_+(((i)>>2)*4096+((i)&3)*1024+512)); }while(0)
  #define KRD(G,j) do{ if constexpr(Q8){ if(G && (j)<2){ kf8[(j)&1]=kload8q(kq0+sl_next+((j)&1)*512); SBAR(); } } else if(G && !(D32 && (j)>=2)){ kload2(kf,kp0+sl_next,j); SBAR(); } }while(0)
  #define MF8(j) __builtin_amdgcn_mfma_scale_f32_32x32x64_f8f6f4(kf8[j],qr8,negm,0,0,0,0,0,0)
  #define STEP(C0,C1,P0,P1,t,GK,GV,GL) do{ SBAR(); \
    const lds_cptr vp_=vp0+sl_prev; \
    VRD(0); SBAR(); float sacc=(P0[0]+P0[1]); \
    GAPA(if constexpr(Q8) C0=MF8(0); else C0=__builtin_amdgcn_mfma_f32_32x32x16_bf16(kf[0],qr[0],negm,0,0,0), P0[2],P0[3],P0[4],P0[5],     pw0[0]=PKW(P0,0), pw0[1]=PKW(P0,2), pw0); \
    VRD(4); SBAR(); GAPA(if constexpr(!Q8) C1=__builtin_amdgcn_mfma_f32_32x32x16_bf16(kf[1],qr[0],negm,0,0,0), P0[6],P0[7],P0[8],P0[9],     pw0[2]=PKW(P0,4), pw0[3]=PKW(P0,6), pw0); \
    VRD(1); SBAR(); GAPA(if constexpr(!Q8) C0=__builtin_amdgcn_mfma_f32_32x32x16_bf16(kf[2],qr[1],C0,0,0,0),   P0[10],P0[11],P0[12],P0[13], pw1[0]=PKW(P0,8), pw1[1]=PKW(P0,10), pw1); \
    VRD(5); SBAR(); GAPA(if constexpr(!Q8) C1=__builtin_amdgcn_mfma_f32_32x32x16_bf16(kf[3],qr[1],C1,0,0,0),   P0[14],P0[15],P1[0],P1[1],   pw1[2]=PKW(P0,12),pw1[3]=PKW(P0,14), pw1); \
    VRD(2); SBAR(); GAPA(if constexpr(Q8) C1=MF8(1); else if constexpr(!D32) C0=__builtin_amdgcn_mfma_f32_32x32x16_bf16(kf[4],qr[2],C0,0,0,0),   P1[2],P1[3],P1[4],P1[5],     pw2[0]=PKW(P1,0), pw2[1]=PKW(P1,2), pw2); \
    VRD(6); SBAR(); GAPA(if constexpr(!D32&&!Q8) C1=__builtin_amdgcn_mfma_f32_32x32x16_bf16(kf[5],qr[2],C1,0,0,0),   P1[6],P1[7],P1[8],P1[9],     pw2[2]=PKW(P1,4), pw2[3]=PKW(P1,6), pw2); \
    VRD(3); SBAR(); GAPA(if constexpr(!D32&&!Q8) C0=__builtin_amdgcn_mfma_f32_32x32x16_bf16(kf[6],qr[3],C0,0,0,0),   P1[10],P1[11],P1[12],P1[13], pw3[0]=PKW(P1,8), pw3[1]=PKW(P1,10), pw3); \
    VRD(7); SBAR(); GAPA(if constexpr(!D32&&!Q8) C1=__builtin_amdgcn_mfma_f32_32x32x16_bf16(kf[7],qr[3],C1,0,0,0),   P1[14],P1[15],0.f,0.f,       pw3[2]=PKW(P1,12),pw3[3]=PKW(P1,14), pw3); \
    l_reg+=sacc; \
    if(GK){DMA_K((t)+3,sl_cur);} if(GV){DMA_V((t)+1,sl_next);} \
    CMASK(C0,C1,t); \
    SBAR(); \
    GAPB(o[0]=__builtin_amdgcn_mfma_f32_32x32x16_bf16(PAF(0),VFR(0),o[0],0,0,0), C0,0); \
    GAPB(o[1]=__builtin_amdgcn_mfma_f32_32x32x16_bf16(PAF(0),VFR(4),o[1],0,0,0), C0,4); \
    KRD(GL,0); GAPB(o[0]=__builtin_amdgcn_mfma_f32_32x32x16_bf16(PAF(1),VFR(1),o[0],0,0,0), C0,8); \
    KRD(GL,1); GAPB(o[1]=__builtin_amdgcn_mfma_f32_32x32x16_bf16(PAF(1),VFR(5),o[1],0,0,0), C0,12); \
    KRD(GL,2); GAPB(o[0]=__builtin_amdgcn_mfma_f32_32x32x16_bf16(PAF(2),VFR(2),o[0],0,0,0), C1,0); \
    KRD(GL,3); GAPB(o[1]=__builtin_amdgcn_mfma_f32_32x32x16_bf16(PAF(2),VFR(6),o[1],0,0,0), C1,4); \
    GAPB(o[0]=__builtin_amdgcn_mfma_f32_32x32x16_bf16(PAF(3),VFR(3),o[0],0,0,0), C1,8); \
    GAPB(o[1]=__builtin_amdgcn_mfma_f32_32x32x16_bf16(PAF(3),VFR(7),o[1],0,0,0), C1,12); \
    }while(0)
  v8i_t vf8[2]; int p8[8]; f32x16 lacc=zero16(); v8i_t ones8; { int o0_,o1_,o2_,o3_,o4_,o5_,o6_,o7_; asm volatile("v_mov_b32 %0, 0x38383838\n\tv_mov_b32 %1, 0x38383838\n\tv_mov_b32 %2, 0x38383838\n\tv_mov_b32 %3, 0x38383838\n\tv_mov_b32 %4, 0x38383838\n\tv_mov_b32 %5, 0x38383838\n\tv_mov_b32 %6, 0x38383838\n\tv_mov_b32 %7, 0x38383838":"=v"(o0_),"=v"(o1_),"=v"(o2_),"=v"(o3_),"=v"(o4_),"=v"(o5_),"=v"(o6_),"=v"(o7_)); ones8=(v8i_t){o0_,o1_,o2_,o3_,o4_,o5_,o6_,o7_}; }
  #define PK8(P,B) __builtin_amdgcn_cvt_pk_bf8_f32(P[(B)+2],P[(B)+3],__builtin_amdgcn_cvt_pk_bf8_f32(P[B],P[(B)+1],0,false),true)
  #define P8V (v8i_t){p8[0],p8[1],p8[2],p8[3],p8[4],p8[5],p8[6],p8[7]}
  #define MFPV(d0) o[d0]=__builtin_amdgcn_mfma_scale_f32_32x32x64_f8f6f4(P8V,vf8[d0],o[d0],1,0,0,0,0,0)
  #define GAPQ(MF,A0,A1,A2,A3,W,PWI) do{ MF; W; PIN(p8[PWI]); SBAR(); }while(0)
  #define MFL() lacc=__builtin_amdgcn_mfma_scale_f32_32x32x64_f8f6f4(P8V,ones8,lacc,1,0,0,0,0,0)
  #define STEP8(C0,C1,P0,P1,t,GK,GV,GL) do{ SBAR(); \
    const lds_cptr vq_=vq0+sl_prev; \
    vf8[0]=kload8q(vq_); SBAR(); \
    GAPQ(C0=MF8(0), P0[2],P0[3],P0[4],P0[5],     p8[0]=PK8(P0,0), 0); \
    vf8[1]=kload8q(vq_+512); SBAR(); \
    GAPQ((void)0,   P0[6],P0[7],P0[8],P0[9],     p8[1]=PK8(P0,4), 1); \
    GAPQ((void)0,   P0[10],P0[11],P0[12],P0[13], p8[2]=PK8(P0,8), 2); \
    GAPQ((void)0,   P0[14],P0[15],P1[0],P1[1],   p8[3]=PK8(P0,12),3); \
    GAPQ(C1=MF8(1), P1[2],P1[3],P1[4],P1[5],     p8[4]=PK8(P1,0), 4); \
    GAPQ((void)0,   P1[6],P1[7],P1[8],P1[9],     p8[5]=PK8(P1,4), 5); \
    GAPQ((void)0,   P1[10],P1[11],P1[12],P1[13], p8[6]=PK8(P1,8), 6); \
    GAPQ((void)0,   P1[14],P1[15],0.f,0.f,       p8[7]=PK8(P1,12),7); \
    if(GK){DMA_K((t)+3,sl_cur);} if(GV){DMA_V((t)+1,sl_next);} \
    SBAR(); \
    GAPB(MFPV(0), C0,0); \
    GAPB(MFL(), C0,4); \
    KRD(GL,0); GAPB((void)0, C0,8); \
    KRD(GL,1); GAPB((void)0, C0,12); \
    GAPB(MFPV(1), C1,0); \
    GAPB((void)0, C1,4); \
    GAPB((void)0, C1,8); \
    GAPB((void)0, C1,12); \
    }while(0)
  int t=1;
  if constexpr(Q8){
  for(;t+5<NT;t+=2){
    STEP8(pB0,pB1,pA0,pA1,t,true,true,true);     WAIT_BAR(1); ROT();
    STEP8(pA0,pA1,pB0,pB1,t+1,true,true,true);   WAIT_BAR(1); ROT();
  }
  for(;t+1<NT;t+=2){
    STEP8(pB0,pB1,pA0,pA1,t,(t+3<NT),(t+1<NT),(t+1<NT));       WAIT_BAR(0); ROT();
    STEP8(pA0,pA1,pB0,pB1,t+1,(t+4<NT),(t+2<NT),(t+2<NT));     WAIT_BAR(0); ROT();
  }
  STEP8(pB0,pB1,pA0,pA1,NT-1,false,false,false);
  { _Pragma("unroll") for(int i=0;i<4;++i){p8[i]=PK8(pB0,4*i);p8[4+i]=PK8(pB1,4*i);}
    vf8[0]=kload8q(vq0+sl_cur);vf8[1]=kload8q(vq0+sl_cur+512); SBAR(); MFPV(0); MFL(); MFPV(1); }
  } else {
  for(;t+5<NT;t+=2){
    STEP(pB0,pB1,pA0,pA1,t,true,true,true);     if(kdma){WAIT_BAR(2);}else{WAIT_BAR(1);} ROT();
    STEP(pA0,pA1,pB0,pB1,t+1,true,true,true);   if(kdma){WAIT_BAR(2);}else{WAIT_BAR(1);} ROT();
  }
  #define ENDW(tt) do{ if(kdma){ if((tt)+3<NT){WAIT_BAR(2);} else if((tt)+2<NT){WAIT_BAR(1);} else {WAIT_BAR(0);} } else { if((tt)+2<NT){WAIT_BAR(1);} else {WAIT_BAR(0);} } }while(0)
  for(;t+1<NT;t+=2){
    STEP(pB0,pB1,pA0,pA1,t,(t+3<NT),(t+1<NT),(t+1<NT));       ENDW(t);   ROT();
    STEP(pA0,pA1,pB0,pB1,t+1,(t+4<NT),(t+2<NT),(t+2<NT));     ENDW(t+1); ROT();
  }
  STEP(pB0,pB1,pA0,pA1,NT-1,false,false,false);
  { float sacc=pB0[0]+pB0[1]; _Pragma("unroll") for(int r=2;r<16;++r)sacc+=pB0[r]; _Pragma("unroll") for(int r=0;r<16;++r)sacc+=pB1[r]; l_reg+=sacc;
    pw0=(u32x4){PKW(pB0,0),PKW(pB0,2),PKW(pB0,4),PKW(pB0,6)};pw1=(u32x4){PKW(pB0,8),PKW(pB0,10),PKW(pB0,12),PKW(pB0,14)};pw2=(u32x4){PKW(pB1,0),PKW(pB1,2),PKW(pB1,4),PKW(pB1,6)};pw3=(u32x4){PKW(pB1,8),PKW(pB1,10),PKW(pB1,12),PKW(pB1,14)};
    SBAR(); pv(o,vb0+sl_cur,PAF(0),PAF(1),PAF(2),PAF(3)); }
  }
  #undef STEP8
  #undef GAPQ
  #undef MFL
  #undef MFPV
  #undef P8V
  #undef PK8
  #undef PKW
  #undef PAF
  #undef VFR
  #undef PIN
  #undef MX3
  #undef GAPA
  #undef GAPB
  #undef EX
  #undef VRD
  #undef KRD
  #undef STEP
  #undef MF8
  #undef ENDW
  __builtin_amdgcn_s_setprio(0);
  {auto rr=__builtin_amdgcn_permlane32_swap(__float_as_uint(l_reg),__float_as_uint(l_reg),false,false);l_reg=__uint_as_float(rr[0])+__uint_as_float(rr[1]);}
  l_reg+=__builtin_amdgcn_exp2f(sk2-mhat);
  if(hi==0)wsf[32+r32]=l_reg;asm volatile("s_waitcnt lgkmcnt(0)":::"memory");
  float rli[16];
  #pragma unroll
  for(int r=0;r<16;++r)rli[r]=__builtin_amdgcn_rcpf(Q8?lacc[r]:wsf[32+crow(r,hi)]);
  { bf16*stg=(bf16*)(shm+LDS_OST+ost*(NW*4096))+wid*2048;
    #pragma unroll
    for(int r=0;r<16;++r){const int orow=crow(r,hi);
      #pragma unroll
      for(int d0=0;d0<2;++d0)stg[orow*64+d0*32+r32]=(bf16)f2bf(o[d0][r]*rli[r]);} }
  asm volatile("s_waitcnt lgkmcnt(0)\n\ts_barrier":::"memory");
  #undef DMA_K
  #undef DMA_V
  #undef TM
  #undef CMASK
  #undef ROT
}
__device__ __forceinline__ void attn_store_plain(unsigned char*Ou,int opitch,int ost,char*shm,int wid,float osc){
  const int lane=opq(lane_id());
  const bf16*stg=(const bf16*)(shm+LDS_OST+ost*(NW*4096))+wid*2048;
  unsigned char*Ow=Ou+(long)(wid*QBLK)*opitch;
  #pragma unroll
  for(int i=0;i<4;++i){const int row=i*8+(lane>>3),ch=lane&7; const u32x4 v=*(const u32x4*)(stg+row*64+ch*8);
    int p0=__builtin_amdgcn_cvt_pk_fp8_f32(osc*bflo(v[0]),osc*bfhi(v[0]),0,false); p0=__builtin_amdgcn_cvt_pk_fp8_f32(osc*bflo(v[1]),osc*bfhi(v[1]),p0,true);
    int p1=__builtin_amdgcn_cvt_pk_fp8_f32(osc*bflo(v[2]),osc*bfhi(v[2]),0,false); p1=__builtin_amdgcn_cvt_pk_fp8_f32(osc*bflo(v[3]),osc*bfhi(v[3]),p1,true);
    *(v2u*)(Ow+(long)row*opitch+ch*8)=(v2u){(unsigned)p0,(unsigned)p1};}
  asm volatile("s_waitcnt lgkmcnt(0)":::"memory");
}
__device__ __forceinline__ void attn_store_diff(unsigned char*Ou,int opitch,float lam,float post,const float*subln,char*shm,int wid){
  const int lane=opq(lane_id());
  const bf16*s0=(const bf16*)(shm+LDS_OST)+wid*2048; const bf16*s1=(const bf16*)(shm+LDS_OST+NW*4096)+wid*2048;
  unsigned char*Ow=Ou+(long)(wid*QBLK)*opitch;
  #pragma unroll
  for(int i=0;i<4;++i){const int row=i*8+(lane>>3),ch=lane&7;
    const u32x4 a=*(const u32x4*)(s0+row*64+ch*8), b=*(const u32x4*)(s1+row*64+ch*8);
    float d[8]; float ss=0.f;
    #pragma unroll
    for(int j=0;j<4;++j){ d[2*j]=bflo(a[j])-lam*bflo(b[j]); d[2*j+1]=bfhi(a[j])-lam*bfhi(b[j]); ss+=d[2*j]*d[2*j]+d[2*j+1]*d[2*j+1]; }
    ss+=lane_xor<1>(ss); ss+=lane_xor<2>(ss); ss+=lane_xor<4>(ss);
    const float rs=__builtin_amdgcn_rsqf(ss*(1.f/64.f)+1e-6f)*post;
    #pragma unroll
    for(int j=0;j<8;++j) d[j]*=rs*subln[ch*8+j];
    int p0=__builtin_amdgcn_cvt_pk_fp8_f32(d[0],d[1],0,false); p0=__builtin_amdgcn_cvt_pk_fp8_f32(d[2],d[3],p0,true);
    int p1=__builtin_amdgcn_cvt_pk_fp8_f32(d[4],d[5],0,false); p1=__builtin_amdgcn_cvt_pk_fp8_f32(d[6],d[7],p1,true);
    *(v2u*)(Ow+(long)row*opitch+ch*8)=(v2u){(unsigned)p0,(unsigned)p1}; }
  asm volatile("s_waitcnt lgkmcnt(0)":::"memory");
}
#undef WAIT_BAR
}
constexpr int NWAVES = 8, NTHR = 512;
constexpr int DM = 1024, NB = 2, SEQ = 16384, CTX = 256, TB = SEQ + CTX, MROWS = NB * TB, NPAN = MROWS / 256, PANB = TB / 256;
constexpr int MIXC = 2816, GATEC = 4096, NLAYER = 2, PQC = 2048, NEXP = 16384;
constexpr float ALPHA = 1.4142135623730951f, LOG2E = 1.4426950408889634f;
constexpr float C2A = 0.125f * LOG2E, C2B = 0.17677669529663687f * LOG2E;
constexpr int CA_Q = 0, CA_K = 256, CA_V = 384, CB_Q = 512, CB_K = 768, CB_V = 1024, CC_Q = 1280, CC_K = 1536, CC_V = 1664, CD_Q = 1792, CD_K = 2048, CD_V = 2304, CD_G = 2560;
constexpr size_t MiB = 1u << 20;
constexpr size_t WS_CTL = 0, CTL_ZERO_BYTES = 64 * 1024;
constexpr size_t WS_MOD = 1 * MiB;
constexpr size_t WS_SC = WS_MOD + 256 * 1024;
constexpr size_t WS_AX64 = WS_MOD + 320 * 1024;
constexpr size_t WS_AX32 = WS_MOD + 384 * 1024;
constexpr size_t WS_ROPE = 2 * MiB;
constexpr size_t WS_HC = 7 * MiB;
constexpr size_t WS_WIN = 10 * MiB;
constexpr size_t WS_WB = 24 * MiB;
constexpr size_t WS_WO = 26 * MiB;
constexpr size_t WS_WQ = 28 * MiB;
constexpr size_t WS_SK = 32 * MiB;
constexpr size_t WS_PU = 33 * MiB;
constexpr size_t WS_PV = 49 * MiB;
constexpr size_t WS_SU = 65 * MiB, WS_SV = 65 * MiB + 65536;
constexpr size_t WS_WQ8 = 66 * MiB, WS_SWQ = 68 * MiB;
constexpr size_t WS_QK8 = 70 * MiB;
constexpr size_t WS_V8T = 84 * MiB;
constexpr size_t WS_QK8B = 196 * MiB, WS_V8TB = 213 * MiB;
constexpr size_t WS_U = 97 * MiB;
constexpr size_t WS_OCAT = 162 * MiB;
constexpr float OSC_AC = 32.f, OSC_B = 16.f, OSC_D = 16.f;
constexpr size_t WS_BIG = 227 * MiB;
constexpr size_t WS_KV = WS_BIG + 179 * MiB;
constexpr size_t WS_PS = WS_KV + 17 * MiB;
constexpr size_t WS_SEL = WS_BIG + 130 * MiB;
constexpr size_t WS_DOT = WS_BIG + 163 * MiB;
constexpr size_t WS_XQ = WS_BIG + 180 * MiB;
constexpr size_t WS_SX = WS_BIG + 213 * MiB;
constexpr size_t WS_ST = WS_BIG + 214 * MiB;
constexpr size_t WS_U8 = WS_BIG + 216 * MiB;
constexpr size_t WS_END = 487 * MiB;
static_assert((size_t)MROWS * MIXC * 2 <= 179 * MiB && WS_PS + 9 * MiB <= WS_END && WS_SEL + (size_t)MROWS * 128 * 8 <= WS_END && WS_BIG + (size_t)MROWS * GATEC * 2 <= WS_END, "ws map");
constexpr int CW_BAR = 1024;
constexpr int CW_RANK = 6144;
constexpr int CW_KM = 8192;
constexpr int SCRATCH_BYTES = 139264, MISC_OFF = SCRATCH_BYTES, LDS_BYTES = 147456;
static_assert(attn_body::LDS_BYTES <= SCRATCH_BYTES && pg8::STAGE_BYTES <= SCRATCH_BYTES, "lds");

struct Params { const float* in[21]; float* out; unsigned char* ws; };
enum { I_X = 0, I_C, I_CTX, I_CCTX, I_WMOD, I_BMOD, I_WIN, I_QKG, I_DLAM, I_DSUB, I_SINK, I_RDEC, I_RNORM, I_WBR, I_WOUT, I_LNA, I_LNF, I_PWQ, I_PSK, I_PU, I_PV };

static __device__ const double kInv32[32] = {1, 0.74989420933245587, 0.56234132519034907, 0.42169650342858223, 0.31622776601683794, 0.23713737056616552, 0.17782794100389229, 0.1333521432163324, 0.10000000000000001, 0.074989420933245579, 0.056234132519034911, 0.042169650342858224, 0.031622776601683791, 0.023713737056616554, 0.017782794100389229, 0.013335214321633241, 0.01, 0.0074989420933245579, 0.005623413251903491, 0.0042169650342858229, 0.0031622776601683794, 0.0023713737056616554, 0.0017782794100389228, 0.0013335214321633241, 0.001, 0.00074989420933245586, 0.0005623413251903491, 0.00042169650342858224, 0.00031622776601683794, 0.00023713737056616554, 0.00017782794100389227, 0.0001333521432163324};

struct Ctx {
    LAS unsigned char* lds; unsigned char* ws; int tid, lane, wave, G, vcu, gw, NGW, bx;
};
__device__ __forceinline__ float* hrow(const Params& P, int r) {
    const int b = r >= TB ? 1 : 0, t = r - b * TB;
    return t < CTX ? (float*)(P.ws + WS_HC) + (size_t)(b * CTX + t) * DM : P.out + (size_t)(b * SEQ + t - CTX) * DM;
}
__device__ __forceinline__ float silu_(float x) { return x * sigmoidf_(x); }
__device__ __forceinline__ float lg2_of(float decay) { return -log1pf(__expf(-decay)) * LOG2E; }

__device__ __forceinline__ void p0_transpose_item(const float* W, int K, int N, bf16* WT, LAS float* scr, int item, int lane, int remap_below = 0, int fp8_from = 1 << 30) {
    const int nblk = N / 32, kb = item / nblk, nb = item % nblk, k0 = 64 * kb, n0 = 32 * nb;
    const int nd0 = n0 < remap_below ? ((n0 & ~255) | (((n0 >> 5) & 1) << 7) | (((n0 >> 6) & 3) << 5)) : n0;
#pragma unroll 8
    for (int i = 0; i < 32; ++i) { const int kk = 2 * i + (lane >> 5); scr[kk * 33 + (lane & 31)] = W[(size_t)(k0 + kk) * N + n0 + (lane & 31)]; }
    LDS_WAIT(); asm volatile("" ::: "memory");
    const int c = lane & 7;
#pragma unroll
    for (int j = 0; j < 4; ++j) { const int n = (lane >> 3) + 8 * j; const LAS float* s = scr + (8 * c) * 33 + n;
        v4u o; o.x = pk2(s[0 * 33], s[1 * 33]); o.y = pk2(s[2 * 33], s[3 * 33]); o.z = pk2(s[4 * 33], s[5 * 33]); o.w = pk2(s[6 * 33], s[7 * 33]);
        if (nd0 >= fp8_from) {
            int w0 = __builtin_amdgcn_cvt_pk_fp8_f32(32.f * s[0 * 33], 32.f * s[1 * 33], 0, false); w0 = __builtin_amdgcn_cvt_pk_fp8_f32(32.f * s[2 * 33], 32.f * s[3 * 33], w0, true);
            int w1 = __builtin_amdgcn_cvt_pk_fp8_f32(32.f * s[4 * 33], 32.f * s[5 * 33], 0, false); w1 = __builtin_amdgcn_cvt_pk_fp8_f32(32.f * s[6 * 33], 32.f * s[7 * 33], w1, true);
            *(v2u*)((unsigned char*)(WT + (size_t)fp8_from * K) + (size_t)(nd0 - fp8_from + n) * K + k0 + 8 * c) = (v2u){(unsigned)w0, (unsigned)w1}; }
        else *(v4u*)(WT + (size_t)(nd0 + n) * K + k0 + 8 * c) = o; }
    LDS_WAIT(); asm volatile("" ::: "memory");
}
__device__ __forceinline__ void cvt_stream(const float* src, bf16* dst, size_t n, int gt, int NGT) {
    for (size_t i = (size_t)gt * 8; i < n; i += (size_t)NGT * 8) {
        const f32x4 a = *(const f32x4*)(src + i), b = *(const f32x4*)(src + i + 4);
        v4u o; o.x = pk2(a.x, a.y); o.y = pk2(a.z, a.w); o.z = pk2(b.x, b.y); o.w = pk2(b.z, b.w);
        *(v4u*)(dst + i) = o; }
}
__device__ __forceinline__ void ph_convert(const Params& P, const Ctx& F, int l) {
    LAS float* scr = (LAS float*)(F.lds + F.wave * 16384);
    constexpr int I_IN = 16 * 216, I_BR = 4 * 32, I_O = 16 * 32, I_Q = 16 * 64, NIT = I_IN + 4 * I_BR + I_O + I_Q;
    for (int it = F.gw; it < NIT; it += F.NGW) {
        int r = it;
        if (r < I_IN) { p0_transpose_item(P.in[I_WIN] + (size_t)l * DM * 6912, DM, 6912, (bf16*)(F.ws + WS_WIN), scr, r, F.lane, MIXC, 0); continue; } r -= I_IN;
        if (r < 4 * I_BR) { const int i = r / I_BR; p0_transpose_item(P.in[I_WBR] + (size_t)(l * 4 + i) * 256 * DM, 256, DM, (bf16*)(F.ws + WS_WB + (size_t)i * DM * 256), scr, r % I_BR, F.lane, 0, 0); continue; }   r -= 4 * I_BR;
        if (r < I_O) { p0_transpose_item(P.in[I_WOUT] + (size_t)l * DM * DM, DM, DM, (bf16*)(F.ws + WS_WO), scr, r, F.lane, 0, 0); continue; } r -= I_O;
        p0_transpose_item(P.in[I_PWQ] + (size_t)l * DM * PQC, DM, PQC, (bf16*)(F.ws + WS_WQ), scr, r, F.lane);
    }
    if (F.gw == 0) {
        const float g1 = P.in[I_QKG][l * 128 + 64 + F.lane]; const float ga = wave_max(g1 * g1) * 64.f * 1.02f;
        if (F.lane == 0) { unsigned* KM = (unsigned*)(F.ws + WS_CTL) + CW_KM + l * 12; atomicMax(KM + 0, __builtin_bit_cast(unsigned, ga)); atomicMax(KM + 1, __builtin_bit_cast(unsigned, ga)); } }
    const int gt = F.gw * 64 + F.lane, NGT = F.NGW * 64;
    cvt_stream(P.in[I_PSK] + (size_t)l * 262144, (bf16*)(F.ws + WS_SK), 262144, gt, NGT);
#define PCV_SRC(e_) (P.in[(e_) >= NEXP ? I_PV : I_PU] + ((size_t)l * NEXP + ((e_) >= NEXP ? (e_) - NEXP : (e_))) * DM + 16 * F.lane)
    f32x4 vn[4];
    { const int e0 = F.gw < 2 * NEXP ? F.gw : 0; const float* s0 = PCV_SRC(e0);
#pragma unroll
      for (int j = 0; j < 4; ++j) vn[j] = *(const f32x4*)(s0 + 4 * j); }
    for (int e = F.gw; e < 2 * NEXP; e += F.NGW) {
        const bool isv = e >= NEXP; const int ee = isv ? e - NEXP : e;
        f32x4 v[4]; float mx = 0.f;
        { const int en = e + F.NGW < 2 * NEXP ? e + F.NGW : e; const float* sn = PCV_SRC(en);
#pragma unroll
          for (int j = 0; j < 4; ++j) { v[j] = vn[j]; vn[j] = *(const f32x4*)(sn + 4 * j); } }
#pragma unroll
        for (int j = 0; j < 4; ++j) { mx = fmaxf(mx, fmaxf(fmaxf(fabsf(v[j].x), fabsf(v[j].y)), fmaxf(fabsf(v[j].z), fabsf(v[j].w)))); }
        mx = wave_max(mx);
        const float sc = fmaxf(mx, 1e-30f) * (1.f / 127.f), inv = 1.f / sc;
        if (isv) {
            const float s4 = fmaxf(mx, 1e-30f) * (1.f / 6.f), i4 = 1.f / s4; unsigned d0 = 0u, d1 = 0u;
            d0 = __builtin_amdgcn_cvt_scalef32_pk_fp4_f32(d0, v[0].x * i4, v[0].y * i4, 1.0f, 0); d0 = __builtin_amdgcn_cvt_scalef32_pk_fp4_f32(d0, v[0].z * i4, v[0].w * i4, 1.0f, 1);
            d0 = __builtin_amdgcn_cvt_scalef32_pk_fp4_f32(d0, v[1].x * i4, v[1].y * i4, 1.0f, 2); d0 = __builtin_amdgcn_cvt_scalef32_pk_fp4_f32(d0, v[1].z * i4, v[1].w * i4, 1.0f, 3);
            d1 = __builtin_amdgcn_cvt_scalef32_pk_fp4_f32(d1, v[2].x * i4, v[2].y * i4, 1.0f, 0); d1 = __builtin_amdgcn_cvt_scalef32_pk_fp4_f32(d1, v[2].z * i4, v[2].w * i4, 1.0f, 1);
            d1 = __builtin_amdgcn_cvt_scalef32_pk_fp4_f32(d1, v[3].x * i4, v[3].y * i4, 1.0f, 2); d1 = __builtin_amdgcn_cvt_scalef32_pk_fp4_f32(d1, v[3].z * i4, v[3].w * i4, 1.0f, 3);
            *(v2u*)(F.ws + WS_PV + (size_t)ee * (DM / 2) + 8 * F.lane) = (v2u){d0, d1};
            if (F.lane == 0) ((float*)(F.ws + WS_SV))[ee] = s4;
        } else {
        v4u o;
#pragma unroll
        for (int j = 0; j < 4; ++j) { unsigned w = 0;
#pragma unroll
            for (int k = 0; k < 4; ++k) { int q = (int)rintf(v[j][k] * inv); q = q > 127 ? 127 : (q < -127 ? -127 : q); w |= (unsigned)(q & 0xff) << (8 * k); }
            o[j] = w; }
        *(v4u*)(F.ws + WS_PU + (size_t)ee * DM + 16 * F.lane) = o;
        if (F.lane == 0) ((float*)(F.ws + WS_SU))[ee] = sc; }
    }
#undef PCV_SRC
}
__device__ __forceinline__ void sincos_rev(double a, float& s, float& c) {
    double rv = a * 0.15915494309189535; rv -= floor(rv); const float f = (float)rv;
    s = __builtin_amdgcn_sinf(f); c = __builtin_amdgcn_cosf(f);
}
__device__ __forceinline__ void ph_tables(const Params& P, const Ctx& F) {
    LAS float* cond = (LAS float*)F.lds;
    LAS float* part = (LAS float*)(F.lds + 16384);
    for (int i = F.tid; i < 3 * DM; i += NTHR) { const int v = i >> 10, k = i & 1023; const float x = v < 2 ? P.in[I_C][v * DM + k] : P.in[I_CCTX][k]; cond[i] = silu_(x); }
    __syncthreads();
    float* MOD = (float*)(F.ws + WS_MOD);
    for (int u = F.bx; u < 2 * 96; u += F.G) {
        const int l = u / 96, n0 = (u % 96) * 64;
        const float* W = P.in[I_WMOD] + (size_t)l * DM * 6144 + n0 + F.lane;
        float a0 = 0.f, a1 = 0.f, a2 = 0.f;
        const int k0 = F.wave * 128;
#pragma unroll 8
        for (int k = 0; k < 128; ++k) { const float w = W[(size_t)(k0 + k) * 6144]; a0 += cond[k0 + k] * w; a1 += cond[DM + k0 + k] * w; a2 += cond[2 * DM + k0 + k] * w; }
        part[(F.wave * 3 + 0) * 64 + F.lane] = a0; part[(F.wave * 3 + 1) * 64 + F.lane] = a1; part[(F.wave * 3 + 2) * 64 + F.lane] = a2;
        __syncthreads();
        if (F.tid < 192) { const int v = F.tid >> 6, n = F.tid & 63; float s = 0.f;
#pragma unroll
            for (int w = 0; w < 8; ++w) s += part[(w * 3 + v) * 64 + n];
            MOD[(size_t)(l * 3 + v) * 6144 + n0 + n] = s + P.in[I_BMOD][l * 6144 + n0 + n]; }
        __syncthreads();
    }
    if (F.bx == F.G - 1 && F.wave == 0) {
        float* SC = (float*)(F.ws + WS_SC);
        for (int l = 0; l < NLAYER; ++l) { const float* p = P.in[I_DLAM] + l * 128;
            const float a = F.lane < 32 ? p[F.lane] * p[32 + F.lane] : 0.f, b = F.lane < 32 ? p[64 + F.lane] * p[96 + F.lane] : 0.f;
            const float sa = wave_sum(a), sb = wave_sum(b); const float li = 0.8f - 0.6f * __expf(-0.3f * (float)l);
            if (F.lane == 0) { SC[l * 4 + 0] = __expf(sa) - __expf(sb) + li; SC[l * 4 + 1] = 1.f - li; } }
        if (F.lane < 16) SC[16 + F.lane] = lg2_of(P.in[I_RDEC][F.lane]);
    }
    const int gt = F.gw * 64 + F.lane, NGT = F.NGW * 64;
    f32x2* ROPE = (f32x2*)(F.ws + WS_ROPE); f32x2* AX64 = (f32x2*)(F.ws + WS_AX64); f32x2* AX32 = (f32x2*)(F.ws + WS_AX32);
    for (int i = gt; i < TB * 32 + 256 * 16 + 256 * 8; i += NGT) {
        float s, c;
        if (i < TB * 32) { sincos_rev((double)(i >> 5) * kInv32[i & 31], s, c); ROPE[i] = (f32x2){c, s}; }
        else if (i < TB * 32 + 4096) { const int j = i - TB * 32; sincos_rev((double)(j >> 4) * kInv32[2 * (j & 15)], s, c); AX64[j] = (f32x2){c, s}; }
        else { const int j = i - TB * 32 - 4096; sincos_rev((double)(j >> 3) * kInv32[4 * (j & 7)], s, c); AX32[j] = (f32x2){c, s}; }
    }
}
__device__ __forceinline__ void ph_mod0(const Params& P, const Ctx& F) {
    const float* MOD = (const float*)(F.ws + WS_MOD);
    bf16* U = (bf16*)(F.ws + WS_U);
    for (int r = F.gw; r < MROWS; r += F.NGW) {
        const int b = r >= TB ? 1 : 0, t = r - b * TB;
        const float* src = t < CTX ? P.in[I_CTX] + (size_t)(b * CTX + t) * DM : P.in[I_X] + (size_t)(b * SEQ + t - CTX) * DM;
        float* hd = hrow(P, r);
        const float* m = MOD + (size_t)(t < CTX ? 2 : b) * 6144;
#pragma unroll
        for (int j = 0; j < 4; ++j) { const int c = 4 * F.lane + 256 * j;
            const f32x4 v = *(const f32x4*)(src + c), sh = *(const f32x4*)(m + c), sc = *(const f32x4*)(m + DM + c);
            *(f32x4*)(hd + c) = v;
            const f32x4 u = v * (sc + 1.f) + sh;
            int w8 = __builtin_amdgcn_cvt_pk_fp8_f32(u.x, u.y, 0, false); w8 = __builtin_amdgcn_cvt_pk_fp8_f32(u.z, u.w, w8, true);
            *(unsigned*)(F.ws + WS_U8 + (size_t)r * DM + c) = (unsigned)w8; }
    }
}
__device__ __forceinline__ void ph_ret_kv(const Params& P, const Ctx& F, int l) {
    using namespace attn_body;
    const bf16* PROJ = (const bf16*)(F.ws + WS_BIG); float* KV = (float*)(F.ws + WS_KV);
    char* shm = (char*)F.lds; const unsigned lds0 = (unsigned)(uintptr_t)shm;
    LAS float* wt = (LAS float*)(F.lds + 65536);
    const int lane = F.lane, wid = F.wave, r32 = lane & 31, hi = lane >> 5;
    const int dir = wid >> 2, dkb = (wid >> 1) & 1, dvb = wid & 1;
    const lds_cptr shm3 = (lds_cptr)shm;
    const lds_cptr trb = shm3 + ((lane >> 4) & 1) * 32 + (lane & 3) * 8 + (4 * hi + ((lane & 15) >> 2)) * 64;
    for (int u = F.vcu; u < NB * 4 * PANB; u += F.G) {
        const int c = u % PANB, bh = u / PANB, h = bh & 3, b = bh >> 2; const size_t r0 = (size_t)b * TB + c * 256;
        const float* LG = (const float*)(F.ws + WS_SC) + 16 + l * 8; const float lgf = LG[h], lgb = LG[4 + h];
        const bf16* ksrc = PROJ + (r0 + 16 * (wid & 3) + (lane >> 2)) * MIXC + CD_K + h * 64 + (wid >> 2) * 32 + (lane & 3) * 8;
        const bf16* vsrc = ksrc + (CD_V - CD_K);
#pragma unroll
        for (int t = 0; t < 4; ++t) { glds16(ksrc + (size_t)t * 64 * MIXC, (unsigned)__builtin_amdgcn_readfirstlane(lds0 + t * 8192 + wid * 1024));
                                      glds16(vsrc + (size_t)t * 64 * MIXC, (unsigned)__builtin_amdgcn_readfirstlane(lds0 + 32768 + t * 8192 + wid * 1024)); }
        { const int j = F.tid & 255; wt[F.tid] = F.tid < 256 ? ex2((float)(255 - j) * lgf) : ex2((float)j * lgb); }
        asm volatile("s_waitcnt vmcnt(0) lgkmcnt(0)\n\ts_barrier" ::: "memory");
        f32x16 acc = zero16();
#pragma unroll 4
        for (int ks = 0; ks < 16; ++ks) {
            const int so = (ks >> 2) * 8192 + (ks & 3) * 1024;
            const s16x4 klo = vtr(trb + so + dkb * 4096), khi = vtr(trb + so + dkb * 4096 + 512);
            const s16x4 vlo = vtr(trb + 32768 + so + dvb * 4096), vhi = vtr(trb + 32768 + so + dvb * 4096 + 512);
            const f32x4 w0 = *(const LAS f32x4*)(wt + dir * 256 + 16 * ks + 4 * hi), w1 = *(const LAS f32x4*)(wt + dir * 256 + 16 * ks + 8 + 4 * hi);
            u32x4 aw;
            aw.x = cvtpk_s(bf1((bf16)klo[0]) * w0.x, bf1((bf16)klo[1]) * w0.y); aw.y = cvtpk_s(bf1((bf16)klo[2]) * w0.z, bf1((bf16)klo[3]) * w0.w);
            aw.z = cvtpk_s(bf1((bf16)khi[0]) * w1.x, bf1((bf16)khi[1]) * w1.y); aw.w = cvtpk_s(bf1((bf16)khi[2]) * w1.z, bf1((bf16)khi[3]) * w1.w);
            const bf16x8 bv = (bf16x8){vlo[0], vlo[1], vlo[2], vlo[3], vhi[0], vhi[1], vhi[2], vhi[3]};
            acc = __builtin_amdgcn_mfma_f32_32x32x16_bf16(bv, __builtin_bit_cast(bf16x8, aw), acc, 0, 0, 0);
        }
        float* o = KV + ((((size_t)bh * 2 + dir) * PANB + c) * 64 + 32 * dvb) * 64 + 32 * dkb + r32;
#pragma unroll
        for (int i = 0; i < 16; ++i) o[(size_t)crow(i, hi) * 64] = acc[i];
        asm volatile("s_waitcnt lgkmcnt(0)\n\ts_barrier" ::: "memory");
    }
}
__device__ __forceinline__ void ph_ret_scan(const Params& P, const Ctx& F, int l) {
    const float* KV = (const float*)(F.ws + WS_KV); bf16* PS = (bf16*)(F.ws + WS_PS);
    for (int e = F.bx * NTHR + F.tid; e < 16 * 4096; e += F.G * NTHR) {
        const int seq = e >> 12, el = e & 4095, dv = el >> 6, dk = el & 63, dir = seq & 1, h = (seq >> 1) & 3;
        const float gC = ex2(256.f * ((const float*)(F.ws + WS_SC))[16 + l * 8 + dir * 4 + h]);
        const float* kv = KV + (size_t)seq * PANB * 4096 + dv * 64 + dk; bf16* ps = PS + (size_t)seq * PANB * 4096 + dv * 64 + dk;
        float S = 0.f;
        if (dir == 0) { for (int c = 0; c < PANB; ++c) { ps[(size_t)c * 4096] = (bf16)f2bf(S); S = S * gC + kv[(size_t)c * 4096]; } }
        else { ps[0] = 0; S = kv[0]; for (int c = PANB - 1; c >= 1; --c) { ps[(size_t)c * 4096] = (bf16)f2bf(S); S = S * gC + kv[(size_t)c * 4096]; } }
    }
}
__device__ __forceinline__ void ret_unit(const Params& P, const Ctx& F, int l, int b, int h, int c) {
    using namespace attn_body;
    const bf16* PROJ = (const bf16*)(F.ws + WS_BIG); const bf16* PS = (const bf16*)(F.ws + WS_PS); unsigned char* OCAT = F.ws + WS_OCAT;
    char* shm = (char*)F.lds;
    const int lane = F.lane, r32 = lane & 31, hi = lane >> 5, wid = F.wave;
    const size_t r0 = (size_t)b * TB + c * 256;
    const float* LG = (const float*)(F.ws + WS_SC) + 16 + l * 8; const float lgf = LG[h], lgb = LG[4 + h];
    const unsigned lds0 = (unsigned)(uintptr_t)shm;
    const bf16* ksrc = PROJ + (r0 + lane) * MIXC + CD_K + h * 64 + wid * 8;
    const bf16* vsrc = PROJ + (r0 + 16 * (wid & 3) + (lane >> 2)) * MIXC + CD_V + h * 64 + (wid >> 2) * 32 + (lane & 3) * 8;
#pragma unroll
    for (int t = 0; t < 4; ++t) { glds16(ksrc + (size_t)t * 64 * MIXC, (unsigned)__builtin_amdgcn_readfirstlane(lds0 + t * 8192 + wid * 1024));
                                  glds16(vsrc + (size_t)t * 64 * MIXC, (unsigned)__builtin_amdgcn_readfirstlane(lds0 + 32768 + t * 8192 + wid * 1024)); }
    bf16x8 qr[4];
    const bf16* Qw = PROJ + (r0 + wid * 32 + r32) * MIXC + CD_Q + h * 64;
#pragma unroll
    for (int d0 = 0; d0 < 4; ++d0) qr[d0] = *reinterpret_cast<const bf16x8*>(Qw + d0 * 16 + hi * 8);
    asm volatile("s_waitcnt vmcnt(0) lgkmcnt(0)\n\ts_barrier" ::: "memory");
    f32x16 o[2]; o[0] = zero16(); o[1] = zero16();
    const lds_cptr shm3 = (lds_cptr)shm;
    const int vb0 = (int)(lds0 + 32768) + ((lane >> 4) & 1) * 32 + (lane & 3) * 8 + (4 * hi + ((lane & 15) >> 2)) * 64;
    const int qi = wid * 32 + r32;
    for (int t = 0; t < 4; ++t) {
        f32x16 p0, p1;
        { const f32x16 zero = zero16(); qkt(p0, p1, shm3 + t * 8192, qr, zero, r32, hi); }
#pragma unroll
        for (int r = 0; r < 16; ++r) {
            const int d0 = qi - (64 * t + crow(r, hi)), d1 = d0 - 32;
            const float w0 = d0 == 0 ? 2.f : ex2(d0 > 0 ? (float)d0 * lgf : (float)(-d0) * lgb);
            const float w1 = d1 == 0 ? 2.f : ex2(d1 > 0 ? (float)d1 * lgf : (float)(-d1) * lgb);
            p0[r] *= w0; p1[r] *= w1; }
        u32x4 pw0, pw1, pw2, pw3;
        pw0 = (u32x4){cvtpk_s(p0[0], p0[1]), cvtpk_s(p0[2], p0[3]), cvtpk_s(p0[4], p0[5]), cvtpk_s(p0[6], p0[7])};
        pw1 = (u32x4){cvtpk_s(p0[8], p0[9]), cvtpk_s(p0[10], p0[11]), cvtpk_s(p0[12], p0[13]), cvtpk_s(p0[14], p0[15])};
        pw2 = (u32x4){cvtpk_s(p1[0], p1[1]), cvtpk_s(p1[2], p1[3]), cvtpk_s(p1[4], p1[5]), cvtpk_s(p1[6], p1[7])};
        pw3 = (u32x4){cvtpk_s(p1[8], p1[9]), cvtpk_s(p1[10], p1[11]), cvtpk_s(p1[12], p1[13]), cvtpk_s(p1[14], p1[15])};
        SBAR();
        pv(o, vb0 + t * 8192, __builtin_bit_cast(bf16x8, pw0), __builtin_bit_cast(bf16x8, pw1), __builtin_bit_cast(bf16x8, pw2), __builtin_bit_cast(bf16x8, pw3));
    }
#pragma unroll
    for (int dir = 0; dir < 2; ++dir) {
        const bf16* ps = PS + ((((size_t)(b * 4 + h)) * 2 + dir) * PANB + c) * 4096;
        f32x16 T[2]; T[0] = zero16(); T[1] = zero16();
#pragma unroll
        for (int d = 0; d < 2; ++d)
#pragma unroll
            for (int s = 0; s < 4; ++s) { const bf16x8 bb = *reinterpret_cast<const bf16x8*>(ps + (32 * d + r32) * 64 + 16 * s + 8 * hi);
                T[d] = __builtin_amdgcn_mfma_f32_32x32x16_bf16(qr[s], bb, T[d], 0, 0, 0); }
#pragma unroll
        for (int r = 0; r < 16; ++r) { const int q = wid * 32 + crow(r, hi);
            const float xi = dir == 0 ? ex2((float)(q + 1) * lgf) : ex2((float)(256 - q) * lgb);
            o[0][r] += xi * T[0][r]; o[1][r] += xi * T[1][r]; }
    }
    float* stg = (float*)(shm + 65536) + wid * 2048;
#pragma unroll
    for (int r = 0; r < 16; ++r) { const int orow = crow(r, hi); stg[orow * 64 + r32] = o[0][r]; stg[orow * 64 + 32 + r32] = o[1][r]; }
    asm volatile("s_waitcnt lgkmcnt(0)" ::: "memory");
    const float* rn0 = P.in[I_RNORM] + l * 512 + h * 64; const float* rn1 = rn0 + 256;
#pragma unroll
    for (int i = 0; i < 4; ++i) { const int row = i * 8 + (lane >> 3), ch = lane & 7;
        const f32x4 a = *(const f32x4*)(stg + row * 64 + ch * 8), bq = *(const f32x4*)(stg + row * 64 + ch * 8 + 4);
        float v[8] = {a.x, a.y, a.z, a.w, bq.x, bq.y, bq.z, bq.w};
        float s = 0.f;
#pragma unroll
        for (int j = 0; j < 8; ++j) s += v[j];
        s += lane_xor<1>(s); s += lane_xor<2>(s); s += lane_xor<4>(s);
        const float mu = s * (1.f / 64.f); float q2 = 0.f;
#pragma unroll
        for (int j = 0; j < 8; ++j) { v[j] -= mu; q2 += v[j] * v[j]; }
        q2 += lane_xor<1>(q2); q2 += lane_xor<2>(q2); q2 += lane_xor<4>(q2);
        const float rs = __builtin_amdgcn_rsqf(q2 * (1.f / 64.f) + 1e-5f);
        const size_t rr = r0 + wid * 32 + row;
        const v4u gg = *(const v4u*)(PROJ + rr * MIXC + CD_G + h * 64 + ch * 8);
        float outv[8];
#pragma unroll
        for (int j = 0; j < 8; ++j) { const float g = (j & 1) ? bfhi(gg[j >> 1]) : bflo(gg[j >> 1]);
            outv[j] = (v[j] * rs * rn0[ch * 8 + j] + rn1[ch * 8 + j]) * silu_(g); }
        int p0 = __builtin_amdgcn_cvt_pk_fp8_f32(OSC_D * outv[0], OSC_D * outv[1], 0, false); p0 = __builtin_amdgcn_cvt_pk_fp8_f32(OSC_D * outv[2], OSC_D * outv[3], p0, true);
        int p1 = __builtin_amdgcn_cvt_pk_fp8_f32(OSC_D * outv[4], OSC_D * outv[5], 0, false); p1 = __builtin_amdgcn_cvt_pk_fp8_f32(OSC_D * outv[6], OSC_D * outv[7], p1, true);
        *(v2u*)(OCAT + rr * DM + 768 + h * 64 + ch * 8) = (v2u){(unsigned)p0, (unsigned)p1}; }
    asm volatile("s_waitcnt lgkmcnt(0)\n\ts_barrier" ::: "memory");
}

__device__ __forceinline__ void ph_mix(const Params& P, const Ctx& F, int l, bool need_ctx) {
    using namespace attn_body;
    const bf16* PROJ = (const bf16*)(F.ws + WS_BIG); unsigned char* OCAT = F.ws + WS_OCAT;
    const float* SC = (const float*)(F.ws + WS_SC);
    const float lam = SC[l * 4 + 0], post = SC[l * 4 + 1];
    char* shm = (char*)F.lds;
    const int nF = (512 - F.vcu + F.G - 1) / F.G;
    const int NS = 512 + (need_ctx ? 24 : 0);
    const int nS = F.vcu < NS ? (NS - F.vcu + F.G - 1) / F.G : 0;
    for (int ui = 0; ui < 2 * nF + nS; ++ui) {
        int type, b, hd, qb;
        if (ui < 2 * nF) { const int f = F.vcu + (ui % nF) * F.G; type = ui < nF ? 1 : 0; b = f >> 8; hd = (f >> 6) & 3; qb = (f & 63) + 1; }
        else { const int s = F.vcu + (ui - 2 * nF) * F.G;
            if (s < 512) { type = 2; b = s >> 8; hd = (s >> 6) & 3; qb = (s & 63) + 1; }
            else { const int s2 = s - 512; type = s2 < 8 ? 2 : (s2 < 16 ? 0 : 1); b = (s2 & 7) >> 2; hd = s2 & 3; qb = 0; } }
        const size_t r0 = (size_t)b * TB + qb * 256;
        const bf16* base = PROJ + (size_t)b * TB * MIXC;
        const int kvh = hd >> 1;
        const bf16* Qp = PROJ + r0 * MIXC + (type == 0 ? CA_Q : type == 1 ? CB_Q : CC_Q) + hd * 64;
        const bf16* Kp = base + (type == 0 ? CA_K + kvh * 64 : type == 1 ? CB_K + hd * 64 : CC_K + kvh * 64);
        const bf16* Vp = base + (type == 0 ? CA_V + kvh * 64 : type == 1 ? CB_V + hd * 64 : CC_V + kvh * 64);
        int NT = qb ? 260 : 4, woff = 0, q0lat = 0, win = 0; float sk2 = -INFINITY;
        const unsigned* KM = (const unsigned*)(F.ws + WS_CTL) + CW_KM + l * 12;
        const int kmi = type == 0 ? kvh : type == 1 ? 2 + 2 * hd : 10 + kvh;
        if (type == 2) { sk2 = P.in[I_SINK][l * 4 + hd] * LOG2E;
            if (qb) { q0lat = (qb - 1) * 256; const int wlo = (q0lat >= 128 ? q0lat - 128 : 0) >> 6, whi = (q0lat + 384 <= SEQ ? q0lat + 384 : SEQ) >> 6; NT = 4 + whi - wlo; woff = wlo; win = 1; } }
        unsigned char* Op = OCAT + r0 * DM + (type == 0 ? 0 : type == 1 ? 256 : 512) + hd * 64;
        if (type == 2) {
            if (win) attn_core<8, false, true>(Qp, MIXC, Kp, Vp, MIXC, NT, woff, q0lat, win, __builtin_sqrtf(__builtin_bit_cast(float, KM[kmi])), sk2, 0, shm, F.wave);
            else attn_core<8, false, false>(Qp, MIXC, Kp, Vp, MIXC, NT, woff, q0lat, win, __builtin_sqrtf(__builtin_bit_cast(float, KM[kmi])), sk2, 0, shm, F.wave);
        } else {
            const unsigned char* Q8r = type == 1 ? F.ws + WS_QK8B : F.ws + WS_QK8; const int q8p = type == 1 ? 512 : QK8P;
            const unsigned char* Q8u = Q8r + r0 * q8p + hd * 64;
            const unsigned char* K8h = Q8r + (size_t)b * TB * q8p + 256 + (type == 1 ? hd : kvh) * 64;
            const unsigned char* V8h = type == 1 ? F.ws + WS_V8TB + (size_t)((b * 4 + hd) * 64) * VTP : F.ws + WS_V8T + (size_t)((b * 2 + kvh) * 64) * VTP;
            for (int ps = 0; ps < (type == 1 ? 2 : 1); ++ps)
                attn_core<8, false, false, true>(Qp, MIXC, Kp, Vp, MIXC, NT, woff, q0lat, win, __builtin_sqrtf(__builtin_bit_cast(float, KM[kmi + ps])), sk2, ps, shm, F.wave,
                                                 Q8u, K8h, V8h, q8p, type == 1 ? ps : -1);
        }
        if (type == 1) attn_store_diff(Op, DM, lam, post * OSC_B, P.in[I_DSUB] + l * 64, shm, F.wave);
        else attn_store_plain(Op, DM, 0, shm, F.wave, OSC_AC);
    }
    __syncthreads();
    for (int u = F.vcu; u < NB * 4 * PANB; u += F.G) {
        const int c = u % PANB, bh = u / PANB;
        if (c == 0 && !need_ctx) continue;
        ret_unit(P, F, l, bh >> 2, bh & 3, c);
    }
}
template <int ACT> struct EpiStore {
    static constexpr bool PERM = true;
    bf16* O; int ldc; float pre;
    __device__ __forceinline__ void operator()(const pg8::f32x4 (&acc)[2][2][4][2], const pg8::Unit& u, int wr, int wc, int fr_, int fq_) const {
        const int ln_ = opq(lane_id()), fr = ln_ & 15, fq = ln_ >> 4;
        const int row0 = u.pm * 256 + wr * 64 + fr, col0 = u.pn * 256 + wc * 32 + 8 * fq;
#pragma unroll
        for (int ai = 0; ai < 2; ++ai)
#pragma unroll
            for (int m = 0; m < 4; ++m) { bf16* rowp = O + (size_t)(row0 + ai * 128 + m * 16) * ldc + col0;
#pragma unroll
                for (int bj = 0; bj < 2; ++bj) { pg8::f32x4 v0 = acc[ai][bj][m][0], v1 = acc[ai][bj][m][1];
                    if (ACT == 1) {
#pragma unroll
                        for (int j = 0; j < 4; ++j) { v0[j] = sigmoidf_(v0[j] * pre); v1[j] = sigmoidf_(v1[j] * pre); } }
                    if (ACT == 1) {
                        unsigned lo = 0u, hi = 0u;
#pragma unroll
                        for (int j = 0; j < 4; ++j) { lo |= (unsigned)(v0[j] * 255.f + 0.5f) << (8 * j); hi |= (unsigned)(v1[j] * 255.f + 0.5f) << (8 * j); }
                        *(v2u*)((unsigned char*)O + (size_t)(row0 + ai * 128 + m * 16) * ldc + col0 + bj * 128) = (v2u){lo, hi};
                    } else {
                    v4u w; w.x = pg8::cvt_pk_bf16(v0[0], v0[1]); w.y = pg8::cvt_pk_bf16(v0[2], v0[3]); w.z = pg8::cvt_pk_bf16(v1[0], v1[1]); w.w = pg8::cvt_pk_bf16(v1[2], v1[3]);
                    *(v4u*)(rowp + bj * 128) = w; } } }
    }
};
struct EpiProj {
    static constexpr bool PERM = true;
    bf16* PROJ; const f32x2* ROPE; const f32x2* AX64; const f32x2* AX32; const float* QKG; unsigned* KM; unsigned char* QK8; unsigned char* V8T; unsigned char* QK8B; unsigned char* V8TB;
    __device__ __forceinline__ void operator()(const pg8::f32x4 (&acc)[2][2][4][2], const pg8::Unit& u, int wr, int wc, int fr_, int fq_) const {
        const int ln_ = opq(lane_id()), fr = ln_ & 15, fq = ln_ >> 4;
        const int hs = 4 * u.pn + wc;
        int kind = 0, kmi = -1; float scale = 1.f; const float* gp = QKG;
        if (hs < 4) { kind = 1; scale = C2A; } else if (hs < 6) { kind = 1; gp = QKG + 64; }
        else if (hs >= 8 && hs < 12) { kind = 2; scale = C2B; } else if (hs >= 12 && hs < 16) { kind = 2; kmi = 2 + 2 * (hs - 12); }
        else if (hs >= 20 && hs < 24) { kind = 3; scale = C2A; } else if (hs >= 24 && hs < 26) { kind = 3; kmi = 10 + hs - 24; }
        else if (hs >= 28 && hs < 32) { kind = 4; } else if (hs >= 32 && hs < 36) { kind = 4; scale = 0.125f; }
        const int b = u.pm >= PANB ? 1 : 0;
        pg8::f32x4 g[2][2];
#pragma unroll
        for (int bj = 0; bj < 2; ++bj)
#pragma unroll
            for (int n = 0; n < 2; ++n) g[bj][n] = kind == 1 ? *(const pg8::f32x4*)(gp + 32 * bj + 8 * fq + 4 * n) : (pg8::f32x4){1.f, 1.f, 1.f, 1.f};
        float kmx0 = 0.f, kmx1 = 0.f;
#pragma unroll
        for (int ai = 0; ai < 2; ++ai)
#pragma unroll
            for (int m = 0; m < 4; ++m) {
                const int r = u.pm * 256 + ai * 128 + wr * 64 + m * 16 + fr, t = r - b * TB; const bool lat = t >= CTX; const int nl = lat ? t - CTX : 0, prow = nl >> 6, pcol = nl & 63;
                pg8::f32x4 x[2][2];
#pragma unroll
                for (int bj = 0; bj < 2; ++bj)
#pragma unroll
                    for (int n = 0; n < 2; ++n) x[bj][n] = acc[ai][bj][m][n] * (1.f / 32.f);
                if (kind == 1) {
                    float ss = 0.f;
#pragma unroll
                    for (int bj = 0; bj < 2; ++bj)
#pragma unroll
                        for (int n = 0; n < 2; ++n) ss += (x[bj][n][0] * x[bj][n][0] + x[bj][n][1] * x[bj][n][1]) + (x[bj][n][2] * x[bj][n][2] + x[bj][n][3] * x[bj][n][3]);
                    ss += lane_xor<16>(ss); ss += lane_xor<32>(ss);
                    const float rs = __builtin_amdgcn_rsqf(ss * (1.f / 64.f) + 1e-6f);
#pragma unroll
                    for (int bj = 0; bj < 2; ++bj)
#pragma unroll
                        for (int n = 0; n < 2; ++n) x[bj][n] = x[bj][n] * rs * g[bj][n];
                }
                if ((kind == 1 || kind == 3) && lat) {
                    const bool hh = fq >> 1;
#pragma unroll
                    for (int bj = 0; bj < 2; ++bj)
#pragma unroll
                        for (int n = 0; n < 2; ++n) { const f32x4* cp = (const f32x4*)(AX64 + (bj ? pcol : prow) * 16 + 8 * (fq & 1) + 4 * n); const f32x4 c01 = cp[0], c23 = cp[1];
                            const float cc[4] = {c01.x, c01.z, c23.x, c23.z}, sn[4] = {c01.y, c01.w, c23.y, c23.w};
#pragma unroll
                            for (int i = 0; i < 4; ++i) { const float xv = x[bj][n][i], xp = lane_xor<32>(xv); x[bj][n][i] = hh ? xv * cc[i] + xp * sn[i] : xv * cc[i] - xp * sn[i]; } }
                }
                if (kind == 2 && lat) {
                    const bool hh = fq & 1; const int pos = (fq >> 1) ? pcol : prow;
#pragma unroll
                    for (int n = 0; n < 2; ++n) { const f32x4* cp = (const f32x4*)(AX32 + pos * 8 + 4 * n); const f32x4 c01 = cp[0], c23 = cp[1];
                        const float cc[4] = {c01.x, c01.z, c23.x, c23.z}, sn[4] = {c01.y, c01.w, c23.y, c23.w};
#pragma unroll
                        for (int bj = 0; bj < 2; ++bj)
#pragma unroll
                            for (int i = 0; i < 4; ++i) { const float xv = x[bj][n][i], xp = lane_xor<16>(xv); x[bj][n][i] = hh ? xv * cc[i] + xp * sn[i] : xv * cc[i] - xp * sn[i]; } }
                }
                if (kind == 4) {
#pragma unroll
                    for (int n = 0; n < 2; ++n) { const f32x4* cp = (const f32x4*)(ROPE + (size_t)t * 32 + 8 * fq + 4 * n); const f32x4 c01 = cp[0], c23 = cp[1];
                        const float cc[4] = {c01.x, c01.z, c23.x, c23.z}, sn[4] = {c01.y, c01.w, c23.y, c23.w};
#pragma unroll
                        for (int i = 0; i < 4; ++i) { const float x1 = x[0][n][i], x2 = x[1][n][i]; x[0][n][i] = x1 * cc[i] - x2 * sn[i]; x[1][n][i] = x2 * cc[i] + x1 * sn[i]; } }
                }
                bf16* rowp = PROJ + (size_t)r * MIXC + 64 * hs + 8 * fq;
#pragma unroll
                for (int bj = 0; bj < 2; ++bj) { const pg8::f32x4 v0 = x[bj][0] * scale, v1 = x[bj][1] * scale;
                    v4u w; w.x = pg8::cvt_pk_bf16(v0[0], v0[1]); w.y = pg8::cvt_pk_bf16(v0[2], v0[3]); w.z = pg8::cvt_pk_bf16(v1[0], v1[1]); w.w = pg8::cvt_pk_bf16(v1[2], v1[3]);
                    *(v4u*)(rowp + 32 * bj) = w;
                    if (hs == 6 || hs == 7 || (hs >= 16 && hs < 20)) {
                        const int u6 = t & 63, w5 = u6 & 31, pos = 32 * ((w5 >> 2) & 1) + 16 * (u6 >> 5) + (w5 & 3) + 4 * (w5 >> 3);
                        unsigned char* vt = (hs < 8 ? V8T + (size_t)((b * 2 + (hs - 6)) * 64) * attn_body::VTP : V8TB + (size_t)((b * 4 + (hs - 16)) * 64) * attn_body::VTP) + (size_t)(32 * bj + 8 * fq) * attn_body::VTP + (size_t)(t >> 6) * 64 + pos;
                        const int p0 = __builtin_amdgcn_cvt_pk_fp8_f32(v0[0], v0[1], 0, false), p1 = __builtin_amdgcn_cvt_pk_fp8_f32(v0[2], v0[3], 0, false);
                        const int p2 = __builtin_amdgcn_cvt_pk_fp8_f32(v1[0], v1[1], 0, false), p3 = __builtin_amdgcn_cvt_pk_fp8_f32(v1[2], v1[3], 0, false);
                        vt[0] = (unsigned char)p0; vt[attn_body::VTP] = (unsigned char)(p0 >> 8); vt[2 * attn_body::VTP] = (unsigned char)p1; vt[3 * attn_body::VTP] = (unsigned char)(p1 >> 8);
                        vt[4 * attn_body::VTP] = (unsigned char)p2; vt[5 * attn_body::VTP] = (unsigned char)(p2 >> 8); vt[6 * attn_body::VTP] = (unsigned char)p3; vt[7 * attn_body::VTP] = (unsigned char)(p3 >> 8); }
                    if (kind == 1 || kind == 2) {
                        int p0 = __builtin_amdgcn_cvt_pk_fp8_f32(v0[0], v0[1], 0, false); p0 = __builtin_amdgcn_cvt_pk_fp8_f32(v0[2], v0[3], p0, true);
                        int p1 = __builtin_amdgcn_cvt_pk_fp8_f32(v1[0], v1[1], 0, false); p1 = __builtin_amdgcn_cvt_pk_fp8_f32(v1[2], v1[3], p1, true);
                        unsigned char* qd = kind == 1 ? QK8 + (size_t)r * attn_body::QK8P + 64 * hs : QK8B + (size_t)r * 512 + 64 * (hs - 8);
                        *(v2u*)(qd + 32 * bj + 8 * fq) = (v2u){(unsigned)p0, (unsigned)p1}; }
                    if (kmi >= 0) {
                        float mq = 0.f;
                        if (kind == 2) {
#pragma unroll
                            for (int j = 0; j < 4; ++j) { const float a = bflo(w[j]), c = bfhi(w[j]); mq += a * a + c * c; }
                            mq += lane_xor<16>(mq); mq += lane_xor<32>(mq);
                        } else {
#pragma unroll
                        for (int j = 0; j < 4; ++j) { const float a = bflo(w[j]), c = bfhi(w[j]); mq = fmaxf(mq, fmaxf(a * a, c * c)); } }
                        if (bj == 0) kmx0 = fmaxf(kmx0, mq); else kmx1 = fmaxf(kmx1, mq); } }
            }
        if (kmi >= 0) {
            if (kind == 2) { const float m0 = wave_max(kmx0) * 1.15f, m1 = wave_max(kmx1) * 1.15f;     if (ln_ == 0) { atomicMax(KM + kmi, __builtin_bit_cast(unsigned, m0)); atomicMax(KM + kmi + 1, __builtin_bit_cast(unsigned, m1)); } }
            else { const float m0 = wave_max(fmaxf(kmx0, kmx1)) * 64.f; if (ln_ == 0) atomicMax(KM + kmi, __builtin_bit_cast(unsigned, m0)); }
        }
    }
};
struct EpiMerge {
    static constexpr bool PERM = true;
    const unsigned char* G; bf16* Mc; int first; unsigned char* M8; float pre;
    __device__ __forceinline__ void operator()(const pg8::f32x4 (&acc)[2][2][4][2], const pg8::Unit& u, int wr, int wc, int fr_, int fq_) const {
        const int ln_ = opq(lane_id()), fr = ln_ & 15, fq = ln_ >> 4;
        const unsigned row0 = u.pm * 256 + wr * 64 + fr, col0 = u.pn * 256 + wc * 32 + 8 * fq;
        const char* Gb = (const char*)G; char* Mb = (char*)Mc;
#pragma unroll
        for (int ai = 0; ai < 2; ++ai) { const int mb = 0;
            v2u g[4][2]; v4u mo[4][2];
#pragma unroll
            for (int m = mb; m < mb + 4; ++m)
#pragma unroll
                for (int bj = 0; bj < 2; ++bj) { const unsigned r = row0 + ai * 128 + m * 16, c = col0 + bj * 128;
                    g[m][bj] = *(const v2u*)(Gb + (size_t)(r * GATEC + c));
                    mo[m][bj] = first ? (v4u){0u, 0u, 0u, 0u} : *(const v4u*)(Mb + (size_t)(r * DM + c) * 2u); }
#pragma unroll
            for (int m = mb; m < mb + 4; ++m)
#pragma unroll
                for (int bj = 0; bj < 2; ++bj) { const unsigned r = row0 + ai * 128 + m * 16, c = col0 + bj * 128;
                    const pg8::f32x4 v0 = acc[ai][bj][m][0] * pre, v1 = acc[ai][bj][m][1] * pre; const v2u gg = g[m][bj]; const v4u mm = mo[m][bj];
                    v4u w;
                    w.x = pg8::cvt_pk_bf16(bflo(mm.x) + (float)(gg.x & 0xffu) * v0[0], bfhi(mm.x) + (float)((gg.x >> 8) & 0xffu) * v0[1]);
                    w.y = pg8::cvt_pk_bf16(bflo(mm.y) + (float)((gg.x >> 16) & 0xffu) * v0[2], bfhi(mm.y) + (float)(gg.x >> 24) * v0[3]);
                    w.z = pg8::cvt_pk_bf16(bflo(mm.z) + (float)(gg.y & 0xffu) * v1[0], bfhi(mm.z) + (float)((gg.y >> 8) & 0xffu) * v1[1]);
                    w.w = pg8::cvt_pk_bf16(bflo(mm.w) + (float)((gg.y >> 16) & 0xffu) * v1[2], bfhi(mm.w) + (float)(gg.y >> 24) * v1[3]);
                    if (M8) { int p0 = __builtin_amdgcn_cvt_pk_fp8_f32(bflo(w.x), bfhi(w.x), 0, false); p0 = __builtin_amdgcn_cvt_pk_fp8_f32(bflo(w.y), bfhi(w.y), p0, true);
                              int p1 = __builtin_amdgcn_cvt_pk_fp8_f32(bflo(w.z), bfhi(w.z), 0, false); p1 = __builtin_amdgcn_cvt_pk_fp8_f32(bflo(w.w), bfhi(w.w), p1, true);
                              *(v2u*)(M8 + (size_t)r * DM + c) = (v2u){(unsigned)p0, (unsigned)p1}; }
                    else *(v4u*)(Mb + (size_t)(r * DM + c) * 2u) = w; }
        }
    }
};
struct EpiQ8 {
    static constexpr bool PERM = true;
    bf16* O; int ldc; const float* SXr; const float* SWc;
    __device__ __forceinline__ void operator()(const pg8::f32x4 (&acc)[2][2][4][2], const pg8::Unit& u, int wr, int wc, int fr_, int fq_) const {
        typedef int i32x4_ __attribute__((ext_vector_type(4)));
        const int ln_ = opq(lane_id()), fr = ln_ & 15, fq = ln_ >> 4;
        const int row0 = u.pm * 256 + wr * 64 + fr, col0 = u.pn * 256 + wc * 32 + 8 * fq;
#pragma unroll
        for (int bj = 0; bj < 2; ++bj) { const pg8::f32x4 s0 = *(const pg8::f32x4*)(SWc + col0 + bj * 128), s1 = *(const pg8::f32x4*)(SWc + col0 + bj * 128 + 4);
#pragma unroll
            for (int ai = 0; ai < 2; ++ai)
#pragma unroll
                for (int m = 0; m < 4; ++m) { const int r = row0 + ai * 128 + m * 16; const float sx = SXr[r];
                    const i32x4_ a0 = __builtin_bit_cast(i32x4_, acc[ai][bj][m][0]), a1 = __builtin_bit_cast(i32x4_, acc[ai][bj][m][1]);
                    v4u w; w.x = pg8::cvt_pk_bf16((float)a0[0] * sx * s0[0], (float)a0[1] * sx * s0[1]); w.y = pg8::cvt_pk_bf16((float)a0[2] * sx * s0[2], (float)a0[3] * sx * s0[3]);
                    w.z = pg8::cvt_pk_bf16((float)a1[0] * sx * s1[0], (float)a1[1] * sx * s1[1]); w.w = pg8::cvt_pk_bf16((float)a1[2] * sx * s1[2], (float)a1[3] * sx * s1[3]);
                    *(v4u*)(O + (size_t)r * ldc + col0 + bj * 128) = w; } }
    }
};
struct EpiOut {
    static constexpr bool PERM = true;
    float* Hlat; float* Hctx; const float* MODl; float pre;
    __device__ __forceinline__ void operator()(const pg8::f32x4 (&acc)[2][2][4][2], const pg8::Unit& u, int wr, int wc, int fr_, int fq_) const {
        const int ln_ = opq(lane_id()), fr = ln_ & 15, fq = ln_ >> 4;
        const int b = u.pm >= PANB ? 1 : 0, pc = u.pm - b * PANB; const bool isctx = pc == 0;
        float* base = isctx ? Hctx + (size_t)b * CTX * DM : Hlat + ((size_t)b * SEQ + (size_t)(pc - 1) * 256) * DM;
        const float* gate = MODl + (size_t)(isctx ? 2 : b) * 6144 + 2 * DM;
        const int rl0 = wr * 64 + fr, col0 = u.pn * 256 + wc * 32 + 8 * fq;
#pragma unroll
        for (int bj = 0; bj < 2; ++bj) { const int c = col0 + bj * 128;
            const pg8::f32x4 g0 = *(const pg8::f32x4*)(gate + c), g1 = *(const pg8::f32x4*)(gate + c + 4);
#pragma unroll
            for (int ai = 0; ai < 2; ++ai)
#pragma unroll
                for (int m = 0; m < 4; ++m) { float* p = base + (size_t)(rl0 + ai * 128 + m * 16) * DM + c;
                    const pg8::f32x4 h0 = *(const pg8::f32x4*)p, h1 = *(const pg8::f32x4*)(p + 4);
                    *(pg8::f32x4*)p = h0 * ALPHA + g0 * (acc[ai][bj][m][0] * pre);
                    *(pg8::f32x4*)(p + 4) = h1 * ALPHA + g1 * (acc[ai][bj][m][1] * pre); } }
    }
};

__device__ __forceinline__ void ph_ln1(const Params& P, const Ctx& F, int l, bool last) {
    const float* MOD = (const float*)(F.ws + WS_MOD) + (size_t)l * 3 * 6144;
    const float* lg = P.in[I_LNA] + (size_t)l * 2 * DM; const float* lb = lg + DM;
    for (int n = F.gw; n < PQC; n += F.NGW) {
        const bf16* wrow = (const bf16*)(F.ws + WS_WQ) + (size_t)n * DM + 16 * F.lane;
        const v4u w0 = *(const v4u*)wrow, w1 = *(const v4u*)(wrow + 8);
        float f[16]; f[0] = bflo(w0.x); f[1] = bfhi(w0.x); f[2] = bflo(w0.y); f[3] = bfhi(w0.y); f[4] = bflo(w0.z); f[5] = bfhi(w0.z); f[6] = bflo(w0.w); f[7] = bfhi(w0.w);
        f[8] = bflo(w1.x); f[9] = bfhi(w1.x); f[10] = bflo(w1.y); f[11] = bfhi(w1.y); f[12] = bflo(w1.z); f[13] = bfhi(w1.z); f[14] = bflo(w1.w); f[15] = bfhi(w1.w);
        float mx = 0.f;
#pragma unroll
        for (int j = 0; j < 16; ++j) mx = fmaxf(mx, fabsf(f[j]));
        mx = wave_max(mx);
        const float sw = fmaxf(mx, 1e-30f) * (1.f / 127.f), isw = 1.f / sw;
        v4u q;
#pragma unroll
        for (int g = 0; g < 4; ++g) { unsigned w = 0;
#pragma unroll
            for (int k = 0; k < 4; ++k) { const int qi = (int)rintf(f[4 * g + k] * isw); w |= (unsigned)(qi & 0xff) << (8 * k); }
            q[g] = w; }
        *(v4u*)(F.ws + WS_WQ8 + (size_t)n * DM + 16 * F.lane) = q;
        if (F.lane == 0) ((float*)(F.ws + WS_SWQ))[n] = sw;
    }
    for (int r = F.gw; r < MROWS; r += F.NGW) {
        const int b = r >= TB ? 1 : 0, t = r - b * TB; if (last && t < CTX) continue;
        float* hp = hrow(P, r);
        const float* m = MOD + (size_t)(t < CTX ? 2 : b) * 6144;
        f32x4 v[4]; float s = 0.f;
#pragma unroll
        for (int j = 0; j < 4; ++j) { v[j] = *(const f32x4*)(hp + 4 * F.lane + 256 * j); s += (v[j].x + v[j].y) + (v[j].z + v[j].w); }
        const float mean = wave_sum(s) * (1.f / DM); float s2 = 0.f;
#pragma unroll
        for (int j = 0; j < 4; ++j) { v[j] = v[j] - mean; s2 += (v[j].x * v[j].x + v[j].y * v[j].y) + (v[j].z * v[j].z + v[j].w * v[j].w); }
        const float rstd = __builtin_amdgcn_rsqf(wave_sum(s2) * (1.f / DM) + 1e-5f);
#pragma unroll
        for (int j = 0; j < 4; ++j) { const int c = 4 * F.lane + 256 * j;
            const f32x4 h = v[j] * rstd * *(const f32x4*)(lg + c) + *(const f32x4*)(lb + c);
            const f32x4 u = h * (*(const f32x4*)(m + 4 * DM + c) + 1.f) + *(const f32x4*)(m + 3 * DM + c);
            v[j] = u; }
        float mx = 0.f;
#pragma unroll
        for (int j = 0; j < 4; ++j) mx = fmaxf(mx, fmaxf(fmaxf(fabsf(v[j].x), fabsf(v[j].y)), fmaxf(fabsf(v[j].z), fabsf(v[j].w))));
        mx = wave_max(mx);
        const float sx = fmaxf(mx, 1e-30f) * (1.f / 127.f), isx = 1.f / sx;
#pragma unroll
        for (int j = 0; j < 4; ++j) { unsigned w = 0;
#pragma unroll
            for (int k = 0; k < 4; ++k) { const int q = (int)rintf(v[j][k] * isx); w |= (unsigned)(q & 0xff) << (8 * k); }
            *(unsigned*)(F.ws + WS_XQ + (size_t)r * DM + 4 * F.lane + 256 * j) = w; }
        if (F.lane == 0) { ((float*)(F.ws + WS_SX))[r] = sx; ((f32x2*)(F.ws + WS_ST))[r] = (f32x2){mean, rstd}; }
    }
}

__device__ __forceinline__ int f2sort(float x) { const int b = __builtin_bit_cast(int, x); return b ^ ((b >> 31) & 0x7fffffff); }
__device__ __forceinline__ float sort2f(int s) { return __builtin_bit_cast(float, s ^ ((s >> 31) & 0x7fffffff)); }
__device__ __forceinline__ int imax3(int a, int b, int c) { return max(max(a, b), c); }
#define CE_DESC(x, y) do { const int hi__ = max((x), (y)), lo__ = min((x), (y)); (x) = hi__; (y) = lo__; } while (0)
__device__ __forceinline__ void sort16_desc(int* v) {
#pragma unroll
    for (int k = 2; k <= 16; k <<= 1)
#pragma unroll
        for (int j = k >> 1; j >= 1; j >>= 1)
#pragma unroll
            for (int i = 0; i < 16; ++i) { const int p = i ^ j; if (p > i) { if ((i & k) == 0) CE_DESC(v[i], v[p]); else CE_DESC(v[p], v[i]); } }
}
__device__ __forceinline__ void merge16_desc(int* a, const int* b) {
#pragma unroll
    for (int i = 0; i < 16; ++i) a[i] = max(a[i], b[15 - i]);
#pragma unroll
    for (int st = 8; st >= 1; st >>= 1)
#pragma unroll
        for (int i = 0; i < 16; ++i) if ((i & st) == 0) CE_DESC(a[i], a[i | st]);
}
__device__ __forceinline__ void ph_topk(const Params& P, const Ctx& F, bool last) {
    const bf16* QP = (const bf16*)(F.ws + WS_BIG); const bf16* SK = (const bf16*)(F.ws + WS_SK); int2* SEL = (int2*)(F.ws + WS_SEL);
    LAS unsigned char* SKs = F.lds;
    LAS int* LA = (LAS int*)(F.lds + 36864 + F.wave * 12288);
    const int lane = F.lane, r32 = lane & 31, hi = lane >> 5;
    constexpr int IMIN = -2147483647 - 1;
    for (int u = F.vcu; u < (last ? 128 : NPAN) * 8; u += F.G) {
        int pan = u >> 3; const int hd = u & 7; if (last) pan += 1 + (pan >= 64 ? 1 : 0); const size_t row = (size_t)pan * 256 + F.wave * 32 + r32;
        for (int p = 0; p < 2; ++p) {
            __syncthreads();
#pragma unroll
            for (int i = 0; i < 4; ++i) { const int idx = F.tid + NTHR * i, rr = idx >> 4, ch = idx & 15;
                *(LAS v4u*)(SKs + rr * 272 + ch * 16) = *(const v4u*)(SK + ((size_t)(hd * 2 + p) * 128 + rr) * 128 + ch * 8); }
            bf16x8 qf[8];
#pragma unroll
            for (int s = 0; s < 8; ++s) qf[s] = *reinterpret_cast<const bf16x8*>(QP + row * PQC + hd * 256 + p * 128 + 64 * hi + 8 * s);
            __syncthreads();
            int v[64];
#pragma unroll
            for (int nb = 0; nb < 4; ++nb) { f32x16 acc = zero16();
#pragma unroll
                for (int s = 0; s < 8; ++s) { const bf16x8 a = *(const LAS bf16x8*)(SKs + (32 * nb + r32) * 272 + (64 * hi + 8 * s) * 2);
                    acc = __builtin_amdgcn_mfma_f32_32x32x16_bf16(a, qf[s], acc, 0, 0, 0); }
#pragma unroll
                for (int i = 0; i < 16; ++i) v[nb * 16 + i] = (f2sort(acc[i]) & ~127) | (32 * nb + (i & 3) + 8 * (i >> 2) + 4 * hi); }
            LAS int* la = LA + p * 1024;
            sort16_desc(v); sort16_desc(v + 16); sort16_desc(v + 32); sort16_desc(v + 48);
            merge16_desc(v, v + 16); merge16_desc(v + 32, v + 48); merge16_desc(v, v + 32);
#pragma unroll
            for (int it = 0; it < 16; ++it) la[it * 64 + lane] = v[it];
        }
        LDS_WAIT();
        int c[16];
        { LAS int* la = LA + hi * 1024;
#pragma unroll
            for (int i = 0; i < 16; ++i) c[i] = max(la[i * 64 + lane], la[(15 - i) * 64 + (lane ^ 32)]);
#pragma unroll
            for (int st = 8; st >= 1; st >>= 1)
#pragma unroll
                for (int i = 0; i < 16; ++i) if ((i & st) == 0) { const int hi_ = max(c[i], c[i | st]), lo_ = min(c[i], c[i | st]); c[i] = hi_; c[i | st] = lo_; }
#pragma unroll
            for (int i = 0; i < 16; ++i) LA[2048 + i * 64 + lane] = c[i]; }
        LDS_WAIT();
        int ck[27], ce[27];
        { int Pl[16], Ql[16];
#pragma unroll
            for (int i = 0; i < 16; ++i) { Pl[i] = LA[2048 + i * 64 + lane]; Ql[i] = LA[2048 + i * 64 + (lane ^ 32)]; }
            int n = 0;
#pragma unroll
            for (int a = 0; a < 16; ++a)
#pragma unroll
                for (int b = a; b < 16; ++b) if ((a + 1) * (b + 1) <= 16) {
                    const float sum = sort2f(Pl[a] & ~127) + sort2f(Ql[b] & ~127);
                    const int ip = Pl[a] & 127, iq = Ql[b] & 127;
                    int key = (f2sort(sum) & ~31) | n;
                    if (a == b && hi) key = IMIN;
                    ck[n] = key; ce[n] = hi ? (iq * 128 + ip) : (ip * 128 + iq); ++n; } }
        LAS int* CK = LA + 2048; LAS int* CE = LA;
        {
            int kk2[32];
#pragma unroll
            for (int k = 0; k < 27; ++k) { kk2[k] = ck[k]; LA[k * 64 + lane] = ce[k]; }
#pragma unroll
            for (int k = 27; k < 32; ++k) kk2[k] = IMIN;
            sort16_desc(kk2); sort16_desc(kk2 + 16); merge16_desc(kk2, kk2 + 16);
            LDS_WAIT();
            int we[16];
#pragma unroll
            for (int it = 0; it < 16; ++it) we[it] = LA[(kk2[it] & 31) * 64 + lane];
            LDS_WAIT();
#pragma unroll
            for (int it = 0; it < 16; ++it) { CK[it * 64 + lane] = kk2[it]; CE[it * 64 + lane] = we[it]; }
        }
        LDS_WAIT();
        float fv[16]; int fe[16]; float mx = -INFINITY;
#pragma unroll
        for (int i = 0; i < 16; ++i) { const int k0 = CK[i * 64 + lane], k1 = CK[(15 - i) * 64 + (lane ^ 32)]; const int e0 = CE[i * 64 + lane], e1 = CE[(15 - i) * 64 + (lane ^ 32)];
            const bool t0 = k0 >= k1; fe[i] = t0 ? e0 : e1; fv[i] = sort2f((t0 ? k0 : k1) & ~31); mx = fmaxf(mx, fv[i]); }
        float den = 0.f;
#pragma unroll
        for (int i = 0; i < 16; ++i) { fv[i] = __expf(fv[i] - mx); den += fv[i]; }
        const float rden = 1.f / den;
        int2* dst = SEL + (row * 8 + hd) * 16 + hi * 8;
#pragma unroll
        for (int i = 0; i < 8; ++i) dst[i] = make_int2(fe[i], __builtin_bit_cast(int, fv[i] * rden));
    }
    __syncthreads();
}

__device__ __forceinline__ float gelu_tanh(float x) { const float t = 1.5957691216057308f * (x + 0.044715f * x * x * x); return x * __builtin_amdgcn_rcpf(1.f + __expf(-t)); }
__device__ __forceinline__ void ph_peer_u(const Params& P, const Ctx& F, bool last) {
    const unsigned char* PU = F.ws + WS_PU; const float* SU = (const float*)(F.ws + WS_SU);
    const int2* SEL = (const int2*)(F.ws + WS_SEL); float* DOT = (float*)(F.ws + WS_DOT);
    const unsigned char* XQ = F.ws + WS_XQ; const float* SX = (const float*)(F.ws + WS_SX);
    const int lane = F.lane, g4 = lane >> 4, t16 = lane & 15;
    int S = 1, s = 0, nx = F.G, myrank = F.bx;
    if ((F.G & 7) == 0) { S = 8; s = F.bx & 7; nx = F.G >> 3; myrank = F.bx >> 3; }
    LAS int* SL = (LAS int*)(F.lds + F.wave * 2048);
    const int stride = nx * NWAVES;
    const unsigned long long lt = (1ull << lane) - 1ull;
#define PEERU_SKIP(rr) do { if (last) { while ((rr) < MROWS && ((rr) - ((rr) >= TB ? TB : 0)) < CTX) (rr) += stride; } } while (0)
#define PEERU_LOADSEL(rr, A0, A1) do { const int rc_ = (rr) < MROWS ? (rr) : MROWS - 1; A0 = SEL[(size_t)rc_ * 128 + lane]; A1 = SEL[(size_t)rc_ * 128 + 64 + lane]; } while (0)
#define PEERU_LOADX(rr, AX, AS) do { const int rc_ = (rr) < MROWS ? (rr) : MROWS - 1; \
        _Pragma("unroll") for (int j_ = 0; j_ < 4; ++j_) AX[j_] = *(const v4u*)(XQ + (size_t)rc_ * DM + 256 * j_ + 16 * t16); AS = SX[rc_]; } while (0)
#define PEERU_COMPACT(buf, A0, A1, CNT) do { LAS int* sle_ = SL + (buf) * 256; const bool i0_ = (((A0).x * S) >> 14) == s, i1_ = (((A1).x * S) >> 14) == s; \
        const unsigned long long m0_ = __ballot(i0_), m1_ = __ballot(i1_); const int c0_ = __popcll(m0_); CNT = c0_ + __popcll(m1_); \
        if (i0_) { const int k_ = __popcll(m0_ & lt); sle_[k_] = (A0).x; sle_[128 + k_] = lane; } \
        if (i1_) { const int k_ = c0_ + __popcll(m1_ & lt); sle_[k_] = (A1).x; sle_[128 + k_] = 64 + lane; } } while (0)
#define PEERU_ROWS(UA, SUA, buf, base, CNT) do { if ((CNT) > (base)) { const LAS int* sle_ = SL + (buf) * 256; \
        _Pragma("unroll") for (int s_ = 0; s_ < 4; ++s_) { if (s_ > 0 && (base) + 4 * s_ >= (CNT)) break;        \
            const int li_ = (base) + 4 * s_ + g4; const int e_ = sle_[li_ < (CNT) ? li_ : (CNT) - 1]; SUA[s_] = SU[e_]; \
            const unsigned ro_ = (unsigned)e_ * (unsigned)DM + 16u * (unsigned)t16; \
            _Pragma("unroll") for (int j_ = 0; j_ < 4; ++j_) UA[4 * s_ + j_] = *(const v4u*)(PU + ro_ + 256 * j_); } } } while (0)
#define PEERU_ROWS0(UA, SUA, buf, CNT) do { const LAS int* sle_ = SL + (buf) * 256; const int lim_ = (CNT) > 0 ? (CNT) - 1 : 0;     \
        _Pragma("unroll") for (int s_ = 0; s_ < 4; ++s_) { const int li_ = 4 * s_ + g4; const int e_ = sle_[li_ < lim_ ? li_ : lim_] & (NEXP - 1); SUA[s_] = SU[e_]; \
            const unsigned ro_ = (unsigned)e_ * (unsigned)DM + 16u * (unsigned)t16; \
            _Pragma("unroll") for (int j_ = 0; j_ < 4; ++j_) UA[4 * s_ + j_] = *(const v4u*)(PU + ro_ + 256 * j_); } } while (0)
#define PEERU_DOTS(UA, XA) do { _Pragma("unroll") for (int s_ = 0; s_ < 4; ++s_) { int sd_ = 0; \
        _Pragma("unroll") for (int j_ = 0; j_ < 4; ++j_) { sd_ = __builtin_amdgcn_sdot4((int)UA[4 * s_ + j_].x, (int)XA[j_].x, sd_, false); sd_ = __builtin_amdgcn_sdot4((int)UA[4 * s_ + j_].y, (int)XA[j_].y, sd_, false); \
            sd_ = __builtin_amdgcn_sdot4((int)UA[4 * s_ + j_].z, (int)XA[j_].z, sd_, false); sd_ = __builtin_amdgcn_sdot4((int)UA[4 * s_ + j_].w, (int)XA[j_].w, sd_, false); } d[s_] = sd_; } } while (0)
#define PEERU_REDUCE_STORE(buf, base, CNT, RR, SXV, SUA) do { const LAS int* sle_ = SL + (buf) * 256; float f_[4]; \
        _Pragma("unroll") for (int s_ = 0; s_ < 4; ++s_) f_[s_] = (float)d[s_] * SUA[s_]; \
        _Pragma("unroll") for (int i = 0; i < 2; ++i) { const bool up = lane & 8; const float send = up ? f_[i] : f_[i + 2], keep = up ? f_[i + 2] : f_[i]; f_[i] = keep + lane_xor<8>(send); } \
        { const bool up = lane & 4; const float send = up ? f_[0] : f_[1], keep = up ? f_[1] : f_[0]; f_[0] = keep + lane_xor<4>(send); } \
        f_[0] += lane_xor<2>(f_[0]); f_[0] += lane_xor<1>(f_[0]); \
        const int my_ = (base) + 4 * (((lane >> 3) & 1) * 2 + ((lane >> 2) & 1)) + g4; \
        if (my_ < (CNT) && (lane & 3) == 0) { const int ei_ = sle_[128 + my_]; DOT[(size_t)(RR) * 128 + ei_] = f_[0] * (SXV); } } while (0)
    int r = myrank * NWAVES + F.wave; PEERU_SKIP(r);
    if (r >= MROWS) return;
    int rn = r + stride; PEERU_SKIP(rn);
    int2 e0, e1, n0, n1; v4u xqA[4], xqB[4]; float sxA, sxB = 0.f; int cnt, cntn = 0;
    v4u ua[16]; float suc[4] = {0.f, 0.f, 0.f, 0.f};
#pragma unroll
    for (int k = 0; k < 16; ++k) ua[k] = (v4u){0u, 0u, 0u, 0u};
#pragma unroll
    for (int k = 0; k < 4; ++k) xqB[k] = (v4u){0u, 0u, 0u, 0u};
    v4u ub[16];
#pragma unroll
    for (int k = 0; k < 16; ++k) ub[k] = (v4u){0u, 0u, 0u, 0u};
    PEERU_LOADSEL(r, e0, e1); PEERU_LOADX(r, xqA, sxA);
    PEERU_LOADSEL(rn, n0, n1);
    PEERU_COMPACT(0, e0, e1, cnt);
    LDS_WAIT();
    PEERU_ROWS0(ua, suc, 0, cnt);
#define PEERU_ITER(CB, XC, SXC, XN, SXN) { \
        int rn2 = rn + stride; PEERU_SKIP(rn2); \
        int2 p0, p1; PEERU_LOADSEL(rn2, p0, p1);                 \
        PEERU_LOADX(rn, XN, SXN);                                \
        PEERU_COMPACT((CB) ^ 1, n0, n1, cntn);                   \
        LDS_WAIT(); \
        int d[4]; float sud[4]; \
        _Pragma("unroll") for (int k = 0; k < 4; ++k) sud[k] = suc[k]; \
        PEERU_DOTS(ua, XC);                                      \
        PEERU_ROWS0(ua, suc, (CB) ^ 1, cntn);                    \
        PEERU_REDUCE_STORE(CB, 0, cnt, r, SXC, sud); \
        if (cnt > 16) {                                          \
            float su2[4] = {0.f, 0.f, 0.f, 0.f}; \
            for (int base = 16; base < cnt; base += 16) { \
                PEERU_ROWS(ub, su2, CB, base, cnt); \
                PEERU_DOTS(ub, XC); \
                PEERU_REDUCE_STORE(CB, base, cnt, r, SXC, su2); \
            } \
        } \
        LDS_WAIT(); \
        r = rn; rn = rn2; cnt = cntn; n0 = p0; n1 = p1; }
    for (;;) {
        PEERU_ITER(0, xqA, sxA, xqB, sxB);
        if (r >= MROWS) break;
        PEERU_ITER(1, xqB, sxB, xqA, sxA);
        if (r >= MROWS) break;
    }
#undef PEERU_ITER
#undef PEERU_LOADSEL
#undef PEERU_LOADX
#undef PEERU_ROWS0
#undef PEERU_SKIP
#undef PEERU_COMPACT
#undef PEERU_ROWS
#undef PEERU_DOTS
#undef PEERU_REDUCE_STORE
}
__device__ __forceinline__ void ph_peer_v(const Params& P, const Ctx& F, int l, bool last) {
    const unsigned char* PV = F.ws + WS_PV; const float* SV = (const float*)(F.ws + WS_SV);
    const int2* SEL = (const int2*)(F.ws + WS_SEL); const float* DOT = (const float*)(F.ws + WS_DOT);
    const float* MOD = (const float*)(F.ws + WS_MOD);
    const float* lg = P.in[I_LNF] + (size_t)l * 2 * DM; const float* lb = lg + DM;
    const int lane = F.lane;
    for (int r = F.gw; r < MROWS; r += F.NGW) {
        const int b = r >= TB ? 1 : 0, t = r - b * TB;
        if (last && t < CTX) continue;
        f32x2 y2[8];
#pragma unroll
        for (int j = 0; j < 8; ++j) y2[j] = (f32x2){0.f, 0.f};
        const int2* selr = SEL + (size_t)r * 128 + (lane & 15); const float* dotr = DOT + (size_t)r * 128 + (lane & 15);
        int2 ent = selr[0]; float dt = dotr[0];
        v2u va[16], vb[16];
#pragma unroll
        for (int k = 0; k < 16; ++k) va[k] = *(const v2u*)(PV + (size_t)__builtin_amdgcn_readlane(ent.x, k) * (DM / 2) + 8 * lane);
#define PEERV_HEAD(VA, VN, HN, PF) do { \
            const int2 entn = selr[(HN) * 16]; const float dtn = dotr[(HN) * 16]; \
            const float wgt = __builtin_bit_cast(float, ent.y) * gelu_tanh(dt) * SV[ent.x];        \
            if (PF) { _Pragma("unroll") for (int k = 0; k < 16; ++k) VN[k] = *(const v2u*)(PV + (size_t)__builtin_amdgcn_readlane(entn.x, k) * (DM / 2) + 8 * lane); } \
            _Pragma("unroll") for (int k = 0; k < 16; ++k) { \
                const float w = __builtin_bit_cast(float, __builtin_amdgcn_readlane(__builtin_bit_cast(int, wgt), k)); const f32x2 w2 = (f32x2){w, w}; \
                _Pragma("unroll") for (int d = 0; d < 2; ++d) { const unsigned q = VA[k][d];       \
                    y2[4 * d] = __builtin_elementwise_fma(w2, __builtin_amdgcn_cvt_scalef32_pk_f32_fp4(q, 1.0f, 0), y2[4 * d]); y2[4 * d + 1] = __builtin_elementwise_fma(w2, __builtin_amdgcn_cvt_scalef32_pk_f32_fp4(q, 1.0f, 1), y2[4 * d + 1]); \
                    y2[4 * d + 2] = __builtin_elementwise_fma(w2, __builtin_amdgcn_cvt_scalef32_pk_f32_fp4(q, 1.0f, 2), y2[4 * d + 2]); y2[4 * d + 3] = __builtin_elementwise_fma(w2, __builtin_amdgcn_cvt_scalef32_pk_f32_fp4(q, 1.0f, 3), y2[4 * d + 3]); } } \
            ent = entn; dt = dtn; } while (0)
#pragma unroll 1
        for (int hp = 0; hp < 3; ++hp) { PEERV_HEAD(va, vb, 2 * hp + 1, true); PEERV_HEAD(vb, va, 2 * hp + 2, true); }
        PEERV_HEAD(va, vb, 7, true); PEERV_HEAD(vb, va, 7, false);
#undef PEERV_HEAD
        float* hp = hrow(P, r);
        const float* m = MOD + ((size_t)l * 3 + (t < CTX ? 2 : b)) * 6144;
        const f32x2 st = ((const f32x2*)(F.ws + WS_ST))[r]; const float* lga = P.in[I_LNA] + (size_t)l * 2 * DM; const float* lba = lga + DM;
        float v[16]; float s = 0.f;
#pragma unroll
        for (int q = 0; q < 4; ++q) { const int c = 16 * lane + 4 * q;
            const f32x4 hv = *(const f32x4*)(hp + c), g = *(const f32x4*)(m + 5 * DM + c);
            const f32x4 h = (hv - st.x) * st.y * *(const f32x4*)(lga + c) + *(const f32x4*)(lba + c);
#pragma unroll
            for (int j = 0; j < 4; ++j) { v[4 * q + j] = ALPHA * h[j] + g[j] * y2[2 * q + (j >> 1)][j & 1]; s += v[4 * q + j]; } }
        const float mean = wave_sum(s) * (1.f / DM); float s2 = 0.f;
#pragma unroll
        for (int j = 0; j < 16; ++j) { v[j] -= mean; s2 += v[j] * v[j]; }
        const float rstd = __builtin_amdgcn_rsqf(wave_sum(s2) * (1.f / DM) + 1e-5f);
        const float* mn = MOD + ((size_t)(l + 1) * 3 + (t < CTX ? 2 : b)) * 6144;
#pragma unroll
        for (int q = 0; q < 4; ++q) { const int c = 16 * lane + 4 * q;
            const f32x4 gg = *(const f32x4*)(lg + c), bb = *(const f32x4*)(lb + c);
            f32x4 h;
#pragma unroll
            for (int j = 0; j < 4; ++j) h[j] = v[4 * q + j] * rstd * gg[j] + bb[j];
            *(f32x4*)(hp + c) = h;
            if (!last) { const f32x4 u = h * (*(const f32x4*)(mn + DM + c) + 1.f) + *(const f32x4*)(mn + c);
                int w8 = __builtin_amdgcn_cvt_pk_fp8_f32(u.x, u.y, 0, false); w8 = __builtin_amdgcn_cvt_pk_fp8_f32(u.z, u.w, w8, true);
                *(unsigned*)(F.ws + WS_U8 + (size_t)r * DM + c) = (unsigned)w8; } }
    }
}
#ifndef PHSEL
#define PHSEL 0xffffffffu
#endif
#define EN(id) (((PHSEL) >> (id)) & 1u)
#ifndef MK_SPLIT
#define MK_SPLIT 0
#endif
constexpr int NPHASE = 2 + NLAYER * 14;
struct KArgs { Params P; int ph_lo, ph_hi; };
__global__ void __launch_bounds__(NTHR, 2) hybrid_fwd(KArgs A_unused) {
    extern __shared__ __attribute__((aligned(16))) unsigned char lds_raw[];
    const __attribute__((address_space(4))) KArgs& A = *(const __attribute__((address_space(4))) KArgs*)__builtin_amdgcn_kernarg_segment_ptr();
    const Params& P0 = (const Params&)A.P;
    Ctx F0;
    F0.lds = (LAS unsigned char*)lds_raw; F0.ws = P0.ws;
    F0.tid = threadIdx.x; F0.lane = F0.tid & 63; F0.wave = __builtin_amdgcn_readfirstlane(F0.tid >> 6);
    F0.G = gridDim.x; { const int bx = blockIdx.x; F0.vcu = (F0.G % 8 == 0) ? (bx % 8) * (F0.G / 8) + bx / 8 : bx; }
    F0.gw = F0.vcu * NWAVES + F0.wave; F0.NGW = F0.G * NWAVES; F0.bx = blockIdx.x;
    volatile LAS unsigned* MISC = (volatile LAS unsigned*)(F0.lds + MISC_OFF);
    for (int u = F0.tid; u < (LDS_BYTES - MISC_OFF) / 4; u += NTHR) MISC[u] = 0u;
    __syncthreads();
    unsigned* ctl = (unsigned*)(P0.ws + WS_CTL);
    XcdBarrier bar; bar.bar = ctl + CW_BAR; bar.x = 0; bar.st = nullptr; bar.w0 = 0u;
    if (!MK_SPLIT) bar = xcd_barrier_post(ctl + CW_BAR, MISC + 8);
    bar.w0 = F0.wave == 0 ? 1u : 0u;
    const int lo = A.ph_lo, hi = A.ph_hi;
    int ph = 0;
#define PHASE(...) do { if (lo <= ph && ph < hi) { const __attribute__((address_space(4))) KArgs* Ap_ = &A; asm volatile("" : "+s"(Ap_)); const Params& P = (const Params&)Ap_->P; Ctx F = F0; F.wave = opqs(F0.wave); F.G = opqs(F0.G); F.vcu = opqs(F0.vcu); F.bx = opqs(F0.bx); F.gw = F.vcu * NWAVES + F.wave; F.NGW = F.G * NWAVES; F.lane = opq(lane_id()); F.tid = F.wave * 64 + F.lane; F.ws = P.ws; \
        bf16* Ub = (bf16*)(P.ws + WS_U); bf16* OC = (bf16*)(P.ws + WS_OCAT); bf16* BIG = (bf16*)(P.ws + WS_BIG); (void)Ub; (void)OC; (void)BIG; __VA_ARGS__; if (ph + 1 < hi) xcd_barrier(bar); } ++ph; } while (0)
    PHASE(if (EN(0)) ph_tables(P, F));
    for (int l = 0; l < NLAYER; ++l) {
        const bool need_ctx = l + 1 < NLAYER, last = !need_ctx;
        PHASE(if (EN(1)) ph_convert(P, F, l));
        PHASE(if (EN(2) && l == 0) ph_mod0(P, F));
        PHASE(if (EN(3)) { pg8::Gemm g{(const bf16*)(P.ws + WS_U8), (const bf16*)(P.ws + WS_WIN), MROWS, MIXC, DM / 2, DM / 2, DM / 2}; pg8::StaticOrder S; S.init(MROWS, MIXC, F.G, F.bx);
                EpiProj E{BIG, (const f32x2*)(P.ws + WS_ROPE), (const f32x2*)(P.ws + WS_AX64), (const f32x2*)(P.ws + WS_AX32), P.in[I_QKG] + l * 128, (unsigned*)(P.ws + WS_CTL) + CW_KM + l * 12, P.ws + WS_QK8, P.ws + WS_V8T, P.ws + WS_QK8B, P.ws + WS_V8TB};
                pg8::gemm_phase<EpiProj, pg8::StaticOrder, true>(F.lds, g, S, E, F.wave); });
        PHASE(if (EN(5)) ph_ret_kv(P, F, l));
        PHASE(if (EN(6)) ph_ret_scan(P, F, l));
        PHASE(if (EN(7)) ph_mix(P, F, l, need_ctx));
        PHASE(if (EN(8)) { pg8::Gemm g{(const bf16*)(P.ws + WS_U8), (const bf16*)(P.ws + WS_WIN) + (size_t)MIXC * (DM / 2), MROWS, GATEC, DM / 2, DM / 2, DM / 2};
                pg8::StaticOrder S; S.init(MROWS, GATEC, F.G, F.bx, last);
                EpiStore<1> E{BIG, GATEC, 1.f / 32.f}; pg8::gemm_phase<EpiStore<1>, pg8::StaticOrder, true>(F.lds, g, S, E, F.wave); });
        PHASE(if (EN(9)) { for (int i = 0; i < 4; ++i) {
                    pg8::Gemm g{(const bf16*)(P.ws + WS_OCAT + i * 256), (const bf16*)(P.ws + WS_WB + (size_t)i * DM * 256), MROWS, DM, 128, DM / 2, 128}; pg8::StaticOrder S; S.init(MROWS, DM, F.G, F.bx, last);
                    EpiMerge E{(const unsigned char*)BIG + i * DM, Ub, i == 0, i == 3 ? (unsigned char*)(P.ws + WS_U8) : (unsigned char*)nullptr, 1.f / (255.f * 32.f * (i == 1 ? OSC_B : i == 3 ? OSC_D : OSC_AC))};
                    pg8::gemm_phase<EpiMerge, pg8::StaticOrder, true>(F.lds, g, S, E, F.wave);
                    VM_WAIT(); __builtin_amdgcn_fence(__ATOMIC_ACQUIRE, "agent"); VM_WAIT(); __syncthreads(); } });
        PHASE(if (EN(10)) { pg8::Gemm g{(const bf16*)(P.ws + WS_U8), (const bf16*)(P.ws + WS_WO), MROWS, DM, DM / 2, DM / 2, DM / 2}; pg8::StaticOrder S; S.init(MROWS, DM, F.G, F.bx, last);
                EpiOut E{P.out, (float*)(P.ws + WS_HC), (const float*)(P.ws + WS_MOD) + (size_t)l * 3 * 6144, 1.f / 32.f}; pg8::gemm_phase<EpiOut, pg8::StaticOrder, true>(F.lds, g, S, E, F.wave); });
        PHASE(if (EN(11)) ph_ln1(P, F, l, last));
        PHASE(if (EN(12)) { pg8::Gemm g{(const bf16*)(P.ws + WS_XQ), (const bf16*)(P.ws + WS_WQ8), MROWS, PQC, DM / 2, DM / 2, DM / 2}; pg8::StaticOrder S; S.init(MROWS, PQC, F.G, F.bx, last);
                EpiQ8 E{BIG, PQC, (const float*)(P.ws + WS_SX), (const float*)(P.ws + WS_SWQ)}; pg8::gemm_phase<EpiQ8, pg8::StaticOrder, false, true>(F.lds, g, S, E, F.wave); });
        PHASE(if (EN(13)) ph_topk(P, F, last));
        PHASE(if (EN(14)) ph_peer_u(P, F, last));
        PHASE(if (EN(14)) ph_peer_v(P, F, l, last));
    }
#undef PHASE
}

extern "C" void kernel_launch(void* const* d_in, const int* in_sizes, int n_in, void* d_out, int out_size, void* d_ws, size_t ws_size, hipStream_t stream) {
    static int grid = 0;
    if (grid == 0) {
        if (n_in != 21 || out_size != NB * SEQ * DM || ws_size < WS_END) { fprintf(stderr, "kernel_launch: unexpected shapes (n_in %d out %d ws %zu)\n", n_in, out_size, ws_size); grid = -1; return; }
        int dev = 0, cus = 0, per_cu = 0;
        if (hipGetDevice(&dev) != hipSuccess || hipDeviceGetAttribute(&cus, hipDeviceAttributeMultiprocessorCount, dev) != hipSuccess) { grid = -1; return; }
        if (hipFuncSetAttribute((const void*)hybrid_fwd, hipFuncAttributeMaxDynamicSharedMemorySize, LDS_BYTES) != hipSuccess) { fprintf(stderr, "kernel_launch: hipFuncSetAttribute failed\n"); grid = -1; return; }
        if (hipOccupancyMaxActiveBlocksPerMultiprocessor(&per_cu, (const void*)hybrid_fwd, NTHR, LDS_BYTES) != hipSuccess || per_cu < 1) { fprintf(stderr, "kernel_launch: occupancy query says %d\n", per_cu); }
        (void)hipGetLastError();
        grid = cus;
    }
    if (grid < 0) return;
    (void)hipMemsetAsync((char*)d_ws + WS_CTL, 0, CTL_ZERO_BYTES, stream);
    KArgs a{};
    for (int i = 0; i < 21; ++i) a.P.in[i] = (const float*)d_in[i];
    a.P.out = (float*)d_out; a.P.ws = (unsigned char*)d_ws;
#if MK_SPLIT
    for (int p = 0; p < NPHASE; ++p) { a.ph_lo = p; a.ph_hi = p + 1; hipLaunchKernelGGL(hybrid_fwd, dim3(grid), dim3(NTHR), LDS_BYTES, stream, a); }
#else
    a.ph_lo = 0; a.ph_hi = NPHASE;
    hipLaunchKernelGGL(hybrid_fwd, dim3(grid), dim3(NTHR), LDS_BYTES, stream, a);
#endif
}
```
